# Optimizing an MI355X kernel written in HIP

```python
import jax, jax.numpy as jnp
from jax import lax
import numpy as np

D_MODEL = 1024
BATCH = 4
SEQ = 4096
DEPTH = 2

N_META = 16
N_A_LAYERS = DEPTH // 2
N_B_LAYERS = DEPTH - N_A_LAYERS
POOL_WINDOWS = (2, 4, 8, 16)
N_POOL_GROUPS = len(POOL_WINDOWS)
POOL_GROUP_DIM = D_MODEL // N_POOL_GROUPS
N_HEADS = 16
HEAD_DIM = D_MODEL // N_HEADS
Q_BLOCK = 128
D_FF = ((8 * D_MODEL // 3 + 127) // 128) * 128
CONV_WIDTH = 3
RMS_EPS = 1e-6

kernel_name = "yoco_pool_stickbreak_convffn"


def rms_norm(x, g):
    xf = x.astype(jnp.float32)
    y = xf * lax.rsqrt(jnp.mean(xf * xf, axis=-1, keepdims=True) + RMS_EPS)
    return (y * g.astype(jnp.float32)).astype(x.dtype)


def multiscale_pool(h, w_groups, scale):
    b, l, d = h.shape
    hf = h.astype(jnp.float32)
    csum = jnp.concatenate([jnp.zeros((b, 1, d), jnp.float32), jnp.cumsum(hf, axis=1)], axis=1)
    hg = hf.reshape(b, l, N_POOL_GROUPS, POOL_GROUP_DIM)
    cg = csum.reshape(b, l + 1, N_POOL_GROUPS, POOL_GROUP_DIM)
    t = jnp.arange(l)
    diffs = []
    for g, w in enumerate(POOL_WINDOWS):
        lo = jnp.maximum(t + 1 - w, 0)
        count = (t + 1 - lo).astype(jnp.float32)
        cgg = cg[:, :, g]
        window_sum = cgg[:, 1:] - cgg[:, lo]
        diffs.append(window_sum / count[None, :, None] - hg[:, :, g])
    diff = jnp.stack(diffs, axis=2).astype(h.dtype)
    y = jnp.einsum('blgc,gcd->blgd', diff, w_groups).reshape(b, l, d)
    return y * scale


def causal_dwconv(u, w, bias):
    l = u.shape[1]
    up = jnp.pad(u, ((0, 0), (CONV_WIDTH - 1, 0), (0, 0)))
    out = bias + w[0] * up[:, 0:l]
    for k in range(1, CONV_WIDTH):
        out = out + w[k] * up[:, k:k + l]
    return out


def conv_ffn(h, w_up, conv_w, conv_b, w_down):
    u = causal_dwconv(h @ w_up, conv_w, conv_b)
    gate, val = jnp.split(u, 2, axis=-1)
    return (jax.nn.silu(gate) * val) @ w_down


def shared_kv(h, kv_norm, w_kv):
    b, l, _ = h.shape
    kv = rms_norm(h, kv_norm) @ w_kv
    k, v = jnp.split(kv, 2, axis=-1)
    k = k.reshape(b, l, N_HEADS, HEAD_DIM).transpose(0, 2, 1, 3)
    v = v.reshape(b, l, N_HEADS, HEAD_DIM).transpose(0, 2, 1, 3)
    return k, v


def stick_breaking_block(q_blk, pos_q, k, v):
    z = jnp.einsum('bhqd,bhsd->bhqs', q_blk, k).astype(jnp.float32) * (HEAD_DIM ** -0.5)
    pos_k = jnp.arange(k.shape[2])
    mask = pos_k[None, :] < pos_q[:, None]
    log_beta = jax.nn.log_sigmoid(z)
    log_1m_beta = jnp.where(mask, jax.nn.log_sigmoid(-z), 0.0)
    later = lax.cumsum(log_1m_beta, axis=3, reverse=True) - log_1m_beta
    a = jnp.where(mask, jnp.exp(log_beta + later), 0.0)
    return jnp.einsum('bhqs,bhsd->bhqd', a.astype(v.dtype), v)


def stick_breaking_attention(h, w_q, k, v, w_o):
    b, l, d = h.shape
    n_real = l - N_META
    n_blk = n_real // Q_BLOCK
    q = (h @ w_q).reshape(b, l, N_HEADS, HEAD_DIM).transpose(0, 2, 1, 3)
    o_meta = stick_breaking_block(q[:, :, :N_META], jnp.arange(N_META),
                                  k[:, :, :N_META], v[:, :, :N_META])
    q_real = q[:, :, N_META:].reshape(b, N_HEADS, n_blk, Q_BLOCK, HEAD_DIM).transpose(2, 0, 1, 3, 4)
    pos_real = (N_META + jnp.arange(n_real)).reshape(n_blk, Q_BLOCK)
    o_real = lax.map(lambda args: stick_breaking_block(args[0], args[1], k, v), (q_real, pos_real))
    o_real = o_real.transpose(1, 2, 0, 3, 4).reshape(b, N_HEADS, n_real, HEAD_DIM)
    o = jnp.concatenate([o_meta, o_real], axis=2).transpose(0, 2, 1, 3).reshape(b, l, d)
    return o @ w_o


def setup_inputs(seed: int = 0) -> dict:
    key = jax.random.key(seed)
    ks = jax.random.split(key, 16)
    f32 = jnp.float32
    nrm = lambda k, shape, s: jax.random.normal(k, shape, f32) * s
    return {
        "x": nrm(ks[0], (BATCH, SEQ, D_MODEL), 1.0),
        "meta_tokens": nrm(ks[1], (N_META, D_MODEL), 1.0),
        "mix_norm": 1.0 + nrm(ks[2], (DEPTH, D_MODEL), 0.05),
        "ffn_norm": 1.0 + nrm(ks[3], (DEPTH, D_MODEL), 0.05),
        "pool_w": nrm(ks[4], (N_A_LAYERS, N_POOL_GROUPS, POOL_GROUP_DIM, POOL_GROUP_DIM), POOL_GROUP_DIM ** -0.5),
        "pool_scale": 1.0 + nrm(ks[5], (N_A_LAYERS, D_MODEL), 0.1),
        "kv_norm": 1.0 + nrm(ks[6], (D_MODEL,), 0.05),
        "w_kv": nrm(ks[7], (D_MODEL, 2 * D_MODEL), D_MODEL ** -0.5),
        "w_q": nrm(ks[8], (N_B_LAYERS, D_MODEL, D_MODEL), D_MODEL ** -0.5),
        "w_o": nrm(ks[9], (N_B_LAYERS, D_MODEL, D_MODEL), D_MODEL ** -0.5),
        "ffn_w_up": nrm(ks[10], (DEPTH, D_MODEL, 2 * D_FF), D_MODEL ** -0.5),
        "ffn_conv_w": nrm(ks[11], (DEPTH, CONV_WIDTH, 2 * D_FF), CONV_WIDTH ** -0.5),
        "ffn_conv_b": nrm(ks[12], (DEPTH, 2 * D_FF), 0.01),
        "ffn_w_down": nrm(ks[13], (DEPTH, D_FF, D_MODEL), D_FF ** -0.5),
        "final_norm": 1.0 + nrm(ks[14], (D_MODEL,), 0.05),
    }


def reference(x, meta_tokens, mix_norm, ffn_norm, pool_w, pool_scale, kv_norm, w_kv,
              w_q, w_o, ffn_w_up, ffn_conv_w, ffn_conv_b, ffn_w_down, final_norm):
    b = x.shape[0]
    meta = jnp.broadcast_to(meta_tokens[None].astype(x.dtype), (b, N_META, D_MODEL))
    h = jnp.concatenate([meta, x], axis=1)
    k = v = None
    for layer in range(DEPTH):
        if layer < N_A_LAYERS:
            h = h + multiscale_pool(rms_norm(h, mix_norm[layer]), pool_w[layer], pool_scale[layer])
        else:
            if layer == N_A_LAYERS:
                k, v = shared_kv(h, kv_norm, w_kv)
            j = layer - N_A_LAYERS
            h = h + stick_breaking_attention(rms_norm(h, mix_norm[layer]), w_q[j], k, v, w_o[j])
        h = h + conv_ffn(rms_norm(h, ffn_norm[layer]), ffn_w_up[layer], ffn_conv_w[layer],
                         ffn_conv_b[layer], ffn_w_down[layer])
    return rms_norm(h, final_norm)[:, N_META:]
```

```cpp
#include <hip/hip_runtime.h>
#include <hip/hip_cooperative_groups.h>
#include <cstdio>
#include <cstdint>
namespace cg = cooperative_groups;
namespace pg8 {
#define PG8_LAS __attribute__((address_space(3)))
typedef unsigned short bf16_t;
typedef short bf16x8 __attribute__((ext_vector_type(8)));
typedef float f32x4 __attribute__((ext_vector_type(4)));
typedef unsigned u32x4 __attribute__((ext_vector_type(4)));
constexpr int BM = 256, BK = 64, HALF = 128, HTB = HALF * BK * 2  , STAGE_BYTES = 8 * HTB, NXCD = 8, WGM = 8;

__host__ __device__ __forceinline__ int lds_byte(int r, int c) { const int st = (r >> 4) * 2 + (c >> 5), rr = r & 15, cc = c & 31, ob = rr * 64 + cc * 2; return st * 1024 + (ob ^ (((ob >> 9) & 1) << 5)); }
__host__ __device__ __forceinline__ void stage_rc(int b, int& R, int& C) { const int st = b / 1024, sb = b % 1024, swz = sb ^ (((sb >> 9) & 1) << 5); R = (st >> 1) * 16 + swz / 64; C = (st & 1) * 32 + (swz % 64) / 2; }
__host__ __device__ __forceinline__ int perm32(int rho) { const int n = rho >> 4, i = rho & 15; return 8 * (i >> 2) + 4 * n + (i & 3); }

struct Unit { int pm, pn; };
struct Gemm { const bf16_t* A; const bf16_t* Bt; int M, N, K, lda, acs; };

struct StaticOrder {
    int nM, nN, nwg, G, c;
    __host__ __device__ void init(int M, int N, int G_, int c_) { nM = M / BM; nN = N / BM; nwg = nM * nN; G = G_; c = c_; }
    __host__ __device__ bool next(int i, Unit& u) const {
        const long L = (long)i * G + c; if (L >= nwg) return false;
        int wgid = (int)L; { const int q = nwg / NXCD, r = nwg % NXCD, xcd = wgid % NXCD, off = wgid / NXCD; wgid = (xcd < r ? xcd * (q + 1) : r * (q + 1) + (xcd - r) * q) + off; }
        const int nig = WGM * nN, gid = wgid / nig, fm = gid * WGM, gsz = (nM - fm) < WGM ? (nM - fm) : WGM;
        u.pm = fm + ((wgid % nig) % gsz); u.pn = (wgid % nig) / gsz; return true;
    }
    __device__ __forceinline__ void a_ready(const Unit&) const {}
    __device__ __forceinline__ void done(const Unit&) const {}
};

__device__ __forceinline__ unsigned cvt_pk_bf16(float lo, float hi) { unsigned r; asm volatile("v_cvt_pk_bf16_f32 %0, %1, %2" : "=v"(r) : "v"(lo), "v"(hi)); return r; }
typedef unsigned u32x2 __attribute__((ext_vector_type(2)));
constexpr float RMS_EPS_C = 1e-6f;
struct EpiRsBf16 {
    static constexpr bool PERM = true, AFTER_DRAIN = false;
    bf16_t* O; int ldc; const float* ssq; int split_cols; size_t split_stride; float scale0; bf16_t* halo;
    __device__ __forceinline__ void operator()(const f32x4 (&acc)[2][2][4][2], const Unit& u, int wr, int wc, int fr, int fq) const {
        const int row0 = u.pm * BM + wr * 64 + fr; int colt = u.pn * BM; bf16_t* base = O;
        float sc = 1.f; if (split_cols) { const int t = colt / split_cols; base += (size_t)t * split_stride; colt -= t * split_cols; if (t == 0) sc = scale0; }
        const int col0 = colt + wc * 32 + 8 * fq;
#pragma unroll
        for (int ai = 0; ai < 2; ++ai)
#pragma unroll
            for (int m = 0; m < 4; ++m) { const int row = row0 + ai * HALF + m * 16; const float rs = __builtin_amdgcn_rsqf(ssq[row] * (1.0f / 1024.0f) + RMS_EPS_C) * sc;
                bf16_t* rowp = base + (size_t)row * ldc + col0;
#pragma unroll
                for (int bj = 0; bj < 2; ++bj) { const f32x4 v0 = acc[ai][bj][m][0] * rs, v1 = acc[ai][bj][m][1] * rs;
                    u32x4 w; w.x = cvt_pk_bf16(v0[0], v0[1]); w.y = cvt_pk_bf16(v0[2], v0[3]); w.z = cvt_pk_bf16(v1[0], v1[1]); w.w = cvt_pk_bf16(v1[2], v1[3]);
                    *(u32x4*)(rowp + bj * HALF) = w;
                    if (halo != nullptr && ai == 1 && m == 3 && wr == 1 && fr >= 14) *(u32x4*)(halo + (size_t)(u.pm * 2 + (fr - 14)) * ldc + col0 + bj * HALF) = w; } }
    }
};
struct EpiRes {
    static constexpr bool PERM = false, AFTER_DRAIN = false;
    const float* base; float* out; bf16_t* hb; float* ssq; const float* cscale; int ldc;
    __device__ __forceinline__ void operator()(const f32x4 (&acc)[2][2][4][2], const Unit& u, int wr, int wc, int fr, int fq) const {
        const int col0 = u.pn * BM + wc * 32 + 4 * fq;
        f32x4 cs[2][2];
#pragma unroll
        for (int bj = 0; bj < 2; ++bj)
#pragma unroll
            for (int n = 0; n < 2; ++n) cs[bj][n] = cscale ? *(const f32x4*)(cscale + col0 + bj * HALF + n * 16) : (f32x4){1.f, 1.f, 1.f, 1.f};
#pragma unroll
        for (int ai = 0; ai < 2; ++ai)
#pragma unroll
            for (int m = 0; m < 4; ++m) { const int r = u.pm * BM + ai * HALF + wr * 64 + m * 16 + fr; const size_t off = (size_t)r * ldc + col0; float q = 0.f;
#pragma unroll
                for (int bj = 0; bj < 2; ++bj)
#pragma unroll
                    for (int n = 0; n < 2; ++n) { const f32x4 bs = *(const f32x4*)(base + off + bj * HALF + n * 16); const f32x4 o = bs + acc[ai][bj][m][n] * cs[bj][n];
                        *(f32x4*)(out + off + bj * HALF + n * 16) = o; q += (o[0] * o[0] + o[1] * o[1]) + (o[2] * o[2] + o[3] * o[3]);
                        if (hb != nullptr) { u32x2 w; w.x = cvt_pk_bf16(o[0], o[1]); w.y = cvt_pk_bf16(o[2], o[3]); *(u32x2*)(hb + off + bj * HALF + n * 16) = w; } }
                q += __shfl_xor(q, 16); q += __shfl_xor(q, 32);
                if (fq == 0) atomicAdd(ssq + r, q);
                if (m & 1) asm volatile("" ::: "memory"); }
    }
};

template <class Epi, class Sched, bool ALIGN_EPI = false, bool SP2 = false>
__device__ __forceinline__ void gemm_phase(PG8_LAS unsigned char* lds, const Gemm g, const Sched& S, const Epi& E) {
    const int tid = threadIdx.x, wid = __builtin_amdgcn_readfirstlane(tid >> 6), lane = tid & 63, wr = wid >> 2, wc = wid & 3, fr = lane & 15, fq = lane >> 4;
    const int K = g.K, nt = K / BK;
    unsigned voffA[2], voffB[2];
#pragma unroll
    for (int i = 0; i < 2; ++i) { int R, C; stage_rc(tid * 16 + i * 8192, R, C); const int Rb = Epi::PERM ? ((R & ~31) + perm32(R & 31)) : R;
        voffA[i] = (unsigned)(R * g.lda + C) * 2u; voffB[i] = (unsigned)(Rb * K + C) * 2u; }
    const size_t kstep = (size_t)(BK * 2);
    const size_t hstepA = (size_t)HALF * g.lda * 2, hstepB = (size_t)HALF * K * 2;
    const size_t tstepA = 2 * hstepA, tstepB = 2 * hstepB; const size_t acsb = (size_t)g.acs * 2;
    const unsigned ldsw = (unsigned)wid * 1024u;
    const int aoff = lds_byte(wr * 64 + fr, fq * 8), boff = lds_byte(wc * 32 + fr, fq * 8);
#define PG8_SA(b, h) (((b) * 2 + (h)) * HTB)
#define PG8_SB(b, h) ((4 + (b) * 2 + (h)) * HTB)
#define PG8_STAGE(bufoff, gbase, voff) do { _Pragma("unroll") for (int _i = 0; _i < 2; ++_i) \
        __builtin_amdgcn_global_load_lds((const unsigned*)((const char*)(gbase) + (voff)[_i]), (PG8_LAS unsigned*)(lds + (bufoff) + ldsw + _i * 8192), 16, 0, 0); } while (0)
#define PG8_LDA(dst, b, h) do { _Pragma("unroll") for (int m = 0; m < 4; ++m) _Pragma("unroll") for (int k = 0; k < 2; ++k) dst[m][k] = *(const PG8_LAS bf16x8*)(lds + PG8_SA(b, h) + aoff + m * 2048 + k * 1024); } while (0)
#define PG8_LDB(dst, b, h) do { _Pragma("unroll") for (int n = 0; n < 2; ++n) _Pragma("unroll") for (int k = 0; k < 2; ++k) dst[n][k] = *(const PG8_LAS bf16x8*)(lds + PG8_SB(b, h) + boff + n * 2048 + k * 1024); } while (0)
#define PG8_MMA(ai, bj, At, Bt) do { __builtin_amdgcn_s_setprio(1); _Pragma("unroll") for (int m = 0; m < 4; ++m) _Pragma("unroll") for (int n = 0; n < 2; ++n) _Pragma("unroll") for (int k = 0; k < 2; ++k) \
        acc[ai][bj][m][n] = __builtin_amdgcn_mfma_f32_16x16x32_bf16(Bt[n][k], At[m][k], acc[ai][bj][m][n], 0, 0, 0); __builtin_amdgcn_s_setprio(0); } while (0)
#define PG8_WAIT_V(n) asm volatile("s_waitcnt vmcnt(" #n ")" ::: "memory")
#define PG8_WAIT_L(n) asm volatile("s_waitcnt lgkmcnt(" #n ")" ::: "memory")
#define PG8_BAR __builtin_amdgcn_s_barrier()
#define PG8_SCHED __builtin_amdgcn_sched_barrier(0)
    Unit cur, nxt; int ui = 0;
    if (!S.next(0, cur)) return;
    f32x4 acc[2][2][4][2];
#pragma unroll
    for (int a = 0; a < 2; ++a)
#pragma unroll
        for (int b = 0; b < 2; ++b)
#pragma unroll
            for (int m = 0; m < 4; ++m)
#pragma unroll
                for (int n = 0; n < 2; ++n) acc[a][b][m][n] = (f32x4){0.f, 0.f, 0.f, 0.f};
    bf16x8 At[4][2], B0[2][2], B1[2][2];
    const char* cA = (const char*)g.A + (size_t)cur.pm * tstepA + (size_t)cur.pn * acsb; const char* cB = (const char*)g.Bt + (size_t)cur.pn * tstepB;
    S.a_ready(cur);
    if constexpr (SP2) {
        PG8_STAGE(PG8_SB(0, 0), cB, voffB); PG8_STAGE(PG8_SB(0, 1), cB + hstepB, voffB); PG8_STAGE(PG8_SA(0, 0), cA, voffA); PG8_STAGE(PG8_SA(0, 1), cA + hstepA, voffA);
        if (wr == 1) PG8_BAR;
        PG8_WAIT_V(2); PG8_BAR;
        PG8_STAGE(PG8_SB(1, 0), cB + kstep, voffB); PG8_STAGE(PG8_SA(1, 0), cA + kstep, voffA); PG8_STAGE(PG8_SB(1, 1), cB + hstepB + kstep, voffB);
        PG8_WAIT_V(6); PG8_BAR;
    } else {
        PG8_STAGE(PG8_SB(0, 0), cB, voffB); PG8_STAGE(PG8_SA(0, 0), cA, voffA); PG8_STAGE(PG8_SB(0, 1), cB + hstepB, voffB); PG8_STAGE(PG8_SA(0, 1), cA + hstepA, voffA);
        if (wr == 1) PG8_BAR;
        PG8_WAIT_V(4); PG8_BAR;
        PG8_STAGE(PG8_SB(1, 0), cB + kstep, voffB); PG8_STAGE(PG8_SA(1, 0), cA + kstep, voffA); PG8_STAGE(PG8_SB(1, 1), cB + hstepB + kstep, voffB);
        PG8_WAIT_V(6); PG8_BAR;
    }
    for (;;) {
        const bool has_next = S.next(ui + 1, nxt);
        const char* nA = has_next ? (const char*)g.A + (size_t)nxt.pm * tstepA + (size_t)nxt.pn * acsb : cA; const char* nB = has_next ? (const char*)g.Bt + (size_t)nxt.pn * tstepB : cB;
        for (int t = 0; t < nt; t += 2) {
            const bool last = (t == nt - 2);
            const char* a1 = cA + (size_t)(t + 1) * kstep;
            const char* a2 = last ? nA : cA + (size_t)(t + 2) * kstep; const char* b2 = last ? nB : cB + (size_t)(t + 2) * kstep;
            const char* a3 = a2 + kstep; const char* b3 = b2 + kstep;
            if (last && has_next) S.a_ready(nxt);
            if constexpr (SP2) {
            PG8_LDB(B0, 0, 0); PG8_LDB(B1, 0, 1); PG8_SCHED; PG8_LDA(At, 0, 0); PG8_STAGE(PG8_SA(1, 1), a1 + hstepA, voffA);
            PG8_WAIT_V(8); PG8_WAIT_L(0); PG8_BAR; PG8_MMA(0, 0, At, B0); PG8_MMA(0, 1, At, B1); PG8_BAR; PG8_SCHED;
            PG8_LDA(At, 0, 1); PG8_STAGE(PG8_SB(0, 0), b2, voffB); PG8_STAGE(PG8_SB(0, 1), b2 + hstepB, voffB); PG8_STAGE(PG8_SA(0, 0), a2, voffA);
            PG8_WAIT_V(8); PG8_WAIT_L(0); PG8_BAR; PG8_MMA(1, 0, At, B0); PG8_MMA(1, 1, At, B1); PG8_BAR; PG8_SCHED;
            PG8_LDB(B0, 1, 0); PG8_LDB(B1, 1, 1); PG8_SCHED; PG8_LDA(At, 1, 0); PG8_STAGE(PG8_SA(0, 1), a2 + hstepA, voffA);
            PG8_WAIT_V(8); PG8_WAIT_L(0); PG8_BAR; PG8_MMA(0, 0, At, B0); PG8_MMA(0, 1, At, B1); PG8_BAR; PG8_SCHED;
            PG8_LDA(At, 1, 1); PG8_STAGE(PG8_SB(1, 0), b3, voffB); PG8_STAGE(PG8_SB(1, 1), b3 + hstepB, voffB); PG8_STAGE(PG8_SA(1, 0), a3, voffA);
            PG8_WAIT_V(8); PG8_WAIT_L(0); PG8_BAR; PG8_MMA(1, 0, At, B0); PG8_MMA(1, 1, At, B1); PG8_BAR; PG8_SCHED;
            } else {
            PG8_LDB(B0, 0, 0); PG8_SCHED; PG8_LDA(At, 0, 0); PG8_STAGE(PG8_SA(1, 1), a1 + hstepA, voffA);
            PG8_WAIT_L(8); PG8_BAR; PG8_WAIT_L(0); PG8_MMA(0, 0, At, B0); PG8_BAR; PG8_SCHED;
            PG8_LDB(B1, 0, 1); PG8_STAGE(PG8_SB(0, 0), b2, voffB);
            PG8_BAR; PG8_WAIT_L(0); PG8_MMA(0, 1, At, B1); PG8_BAR;
            PG8_LDA(At, 0, 1); PG8_STAGE(PG8_SA(0, 0), a2, voffA);
            PG8_BAR; PG8_WAIT_L(0); PG8_MMA(1, 0, At, B0); PG8_BAR; PG8_SCHED;
            PG8_STAGE(PG8_SB(0, 1), b2 + hstepB, voffB);
            PG8_WAIT_V(6); PG8_BAR; PG8_MMA(1, 1, At, B1); PG8_BAR;
            PG8_LDB(B0, 1, 0); PG8_SCHED; PG8_LDA(At, 1, 0); PG8_STAGE(PG8_SA(0, 1), a2 + hstepA, voffA);
            PG8_WAIT_L(8); PG8_BAR; PG8_WAIT_L(0); PG8_MMA(0, 0, At, B0); PG8_BAR; PG8_SCHED;
            PG8_LDB(B1, 1, 1); PG8_STAGE(PG8_SB(1, 0), b3, voffB);
            PG8_BAR; PG8_WAIT_L(0); PG8_MMA(0, 1, At, B1); PG8_BAR;
            PG8_LDA(At, 1, 1); PG8_STAGE(PG8_SA(1, 0), a3, voffA);
            PG8_BAR; PG8_WAIT_L(0); PG8_MMA(1, 0, At, B0); PG8_BAR; PG8_SCHED;
            PG8_STAGE(PG8_SB(1, 1), b3 + hstepB, voffB);
            PG8_WAIT_V(6); PG8_BAR; PG8_MMA(1, 1, At, B1); PG8_BAR;
            }
        }
        if constexpr (ALIGN_EPI) { if (wr == 0) PG8_BAR; }
        if constexpr (!Epi::AFTER_DRAIN) { E(acc, cur, wr, wc, fr, fq); S.done(cur); }
        if (!has_next) break;
#pragma unroll
        for (int a = 0; a < 2; ++a)
#pragma unroll
            for (int b = 0; b < 2; ++b)
#pragma unroll
                for (int m = 0; m < 4; ++m)
#pragma unroll
                    for (int n = 0; n < 2; ++n) acc[a][b][m][n] = (f32x4){0.f, 0.f, 0.f, 0.f};
        cur = nxt; cA = nA; cB = nB; ++ui;
        if constexpr (ALIGN_EPI) { if (wr == 1) PG8_BAR; }
    }
    PG8_WAIT_V(0);
    if constexpr (!ALIGN_EPI) { if (wr == 0) PG8_BAR; }
    PG8_BAR;
    if constexpr (Epi::AFTER_DRAIN) { E.fused(acc, cur, wr, wc, fr, fq, lds, wid, lane); S.done(cur); }
#undef PG8_SA
#undef PG8_SB
#undef PG8_STAGE
#undef PG8_LDA
#undef PG8_LDB
#undef PG8_MMA
#undef PG8_WAIT_V
#undef PG8_WAIT_L
#undef PG8_BAR
#undef PG8_SCHED
}
}

#ifndef MK_N_LAUNCHES
#define MK_N_LAUNCHES 1
#endif
#ifndef ATTN_SIMPLE
#define ATTN_SIMPLE 1
#endif
constexpr int NB = 4, T = 4096, D = 1024, NMETA = 16, NH = 16, HD = 64, FF = 2816, FF2 = 5632;
constexpr int M = NB * T;
constexpr int MROW = M;
constexpr int MR = M + 64;
constexpr float EPS = 1e-6f;
constexpr float C2 = 0.125f * 1.4426950408889634f;
constexpr int NWAVES = 8, NTHREADS = 512, NPHASES = 12;
constexpr size_t WS_WPOOL = 0;
constexpr size_t WS_WUP   = WS_WPOOL + (size_t)4 * 256 * 256 * 2;
constexpr size_t WS_WDOWN = WS_WUP + (size_t)2 * FF2 * D * 2;
constexpr size_t WS_WQKV  = WS_WDOWN + (size_t)2 * D * FF * 2;
constexpr size_t WS_WO    = WS_WQKV + (size_t)3 * D * D * 2;
constexpr size_t WS_HB    = WS_WO + (size_t)D * D * 2;
constexpr size_t WS_U     = WS_HB + (size_t)MR * D * 2;
constexpr size_t WS_HALO  = WS_U + (size_t)MR * FF2 * 2;
constexpr size_t WS_SSQ   = WS_HALO + (size_t)65 * 2 * FF2 * 2;
constexpr size_t WS_HM    = WS_SSQ + (size_t)4 * MR * 4;
constexpr size_t WS_END   = WS_HM + (size_t)16 * D * 4;
constexpr size_t ACT_BYTES = (size_t)MR * D * 2;
static_assert(WS_END <= 268435456, "workspace map exceeds 256 MiB");
static_assert(4 * ACT_BYTES <= (size_t)MR * FF2 * 2, "Q|K|V|O overlay fits in U");
constexpr int LDS_BYTES = 147456;

#define GAS __attribute__((address_space(1)))
#define LAS __attribute__((address_space(3)))
typedef unsigned short bf16;
typedef unsigned v4u __attribute__((ext_vector_type(4)));
typedef unsigned v2u __attribute__((ext_vector_type(2)));
typedef float f32x4 __attribute__((ext_vector_type(4)));
typedef short bf16x8 __attribute__((ext_vector_type(8)));
#define LDS_WAIT() asm volatile("s_waitcnt lgkmcnt(0)" ::: "memory")
__device__ __forceinline__ unsigned pk2(float lo, float hi) { return pg8::cvt_pk_bf16(lo, hi); }
__device__ __forceinline__ float bflo(unsigned w) { return __uint_as_float(w << 16); }
__device__ __forceinline__ float bfhi(unsigned w) { return __uint_as_float(w & 0xffff0000u); }
__device__ __forceinline__ float wave_sum(float v) {
#pragma unroll
    for (int o = 1; o < 64; o <<= 1) v += __shfl_xor(v, o);
    return v;
}
__device__ __forceinline__ float rs_of(float ssq) { return __builtin_amdgcn_rsqf(ssq * (1.0f / (float)D) + EPS); }

__device__ __forceinline__ void p0_transpose_item(const float* W, int K, int N, bf16* WT, int row_off, const float* gain, LAS float* scr, int item, int lane) {
    const int nblk = N / 32, kb = item / nblk, nb = item % nblk, k0 = 64 * kb, n0 = 32 * nb;
#pragma unroll 8
    for (int i = 0; i < 32; ++i) { const int kk = 2 * i + (lane >> 5); float w = W[(size_t)(k0 + kk) * N + n0 + (lane & 31)]; if (gain) w *= gain[k0 + kk]; scr[kk * 33 + (lane & 31)] = w; }
    LDS_WAIT(); asm volatile("" ::: "memory");
    const int c = lane & 7;
#pragma unroll
    for (int j = 0; j < 4; ++j) { const int n = (lane >> 3) + 8 * j; const LAS float* s = scr + (8 * c) * 33 + n;
        v4u o; o.x = pk2(s[0 * 33], s[1 * 33]); o.y = pk2(s[2 * 33], s[3 * 33]); o.z = pk2(s[4 * 33], s[5 * 33]); o.w = pk2(s[6 * 33], s[7 * 33]);
        *(v4u*)(WT + (size_t)(row_off + n0 + n) * K + k0 + 8 * c) = o; }
    LDS_WAIT(); asm volatile("" ::: "memory");
}
template <bool IS_META>
__device__ __forceinline__ void p0_diff_chunk(const float* x, const float* meta, const float* g0, bf16* DIFF, int b, int t0, int lane, LAS float* rsr  ) {
    f32x4 gv[4];
#pragma unroll
    for (int j = 0; j < 4; ++j) gv[j] = *(const f32x4*)(g0 + 4 * lane + 256 * j);
    const f32x4 z4 = {0.f, 0.f, 0.f, 0.f};
    f32x4 S[4];
#pragma unroll
    for (int j = 0; j < 4; ++j) S[j] = z4;
#pragma unroll 2
    for (int k = IS_META ? 16 : 0; k < 32; ++k) {
        const int i = k & 15; const bool outp = k >= 16;
        const int t = IS_META ? (i - 16) : (t0 - 16 + k);
        const float* src = (t >= 0) ? x + ((size_t)b * T + t) * D : meta + (size_t)(16 + t) * D;
        f32x4 v[4]; float s = 0.f;
#pragma unroll
        for (int j = 0; j < 4; ++j) { v[j] = *(const f32x4*)(src + 4 * lane + 256 * j); s += (v[j][0] * v[j][0] + v[j][1] * v[j][1]) + (v[j][2] * v[j][2] + v[j][3] * v[j][3]); }
        const float rs = rs_of(wave_sum(s));
        rsr[i] = rs;
        f32x4 n[4];
#pragma unroll
        for (int j = 0; j < 4; ++j) {
            n[j] = v[j] * rs * gv[j];
            const int w = 2 << j;
            f32x4 old = z4;
            if ((!IS_META && outp) || i >= w) {
                const int to = t - w;
                const float* so = (to >= 0) ? x + ((size_t)b * T + to) * D : meta + (size_t)(16 + to) * D;
                old = *(const f32x4*)(so + 4 * lane + 256 * j) * rsr[(i - w) & 15] * gv[j];
            }
            S[j] += n[j] - old;
        }
        if (outp) {
            const size_t orow = IS_META ? (size_t)(MROW + i) : ((size_t)b * T + t);
#pragma unroll
            for (int j = 0; j < 4; ++j) { const int w = 2 << j; const int cnt = IS_META ? ((i + 1) < w ? (i + 1) : w) : w; const float inv = 1.0f / (float)cnt;
                const f32x4 d = S[j] * inv - n[j]; v2u o; o.x = pk2(d[0], d[1]); o.y = pk2(d[2], d[3]);
                *(v2u*)(DIFF + orow * D + 4 * lane + 256 * j) = o; }
        }
    }
}
template <class F>
__device__ __forceinline__ void thin_item(const bf16* A, int lda, const bf16* Bt, int K, int n0, int lane, F epi) {
    const int m = lane & 15, kq = lane >> 4;
    const bf16* ap = A + (size_t)m * lda + kq * 8; const bf16* bp = Bt + (size_t)(n0 + m) * K + kq * 8;
    f32x4 acc = {0.f, 0.f, 0.f, 0.f};
#pragma unroll 8
    for (int ks = 0; ks < K; ks += 32) { const bf16x8 a = *(const bf16x8*)(ap + ks); const bf16x8 bb = *(const bf16x8*)(bp + ks); acc = __builtin_amdgcn_mfma_f32_16x16x32_bf16(a, bb, acc, 0, 0, 0); }
    epi(4 * kq, n0 + m, acc);
}
__device__ __forceinline__ void thin_res_epi(const float* base, float* hm, bf16* HB, float* ssq, const float* cscale, int row4, int col, const f32x4 acc) {
    const float cs = cscale ? cscale[col] : 1.f; float q[4];
#pragma unroll
    for (int i = 0; i < 4; ++i) { const int r = row4 + i; const float o = base[(size_t)r * D + col] + acc[i] * cs; hm[(size_t)r * D + col] = o; if (HB) HB[(size_t)(MROW + r) * D + col] = (bf16)(pk2(o, 0.f) & 0xffffu); q[i] = o * o; }
#pragma unroll
    for (int i = 0; i < 4; ++i) { float s = q[i]; s += __shfl_xor(s, 1); s += __shfl_xor(s, 2); s += __shfl_xor(s, 4); s += __shfl_xor(s, 8); if ((col & 15) == 0) atomicAdd(ssq + MROW + row4 + i, s); }
}
struct ConvW { float wg[3][8], bg[8], wv[3][8], bv[8]; };
__device__ __forceinline__ void unpack8(const v4u w, float (&f)[8]) { f[0] = bflo(w.x); f[1] = bfhi(w.x); f[2] = bflo(w.y); f[3] = bfhi(w.y); f[4] = bflo(w.z); f[5] = bfhi(w.z); f[6] = bflo(w.w); f[7] = bfhi(w.w); }
__device__ __forceinline__ void convgate_walk(bf16* U, int row0, int nrows, int ch, const float* cw, const float* cb, v4u pg2, v4u pv2, v4u pg1, v4u pv1) {
    float wg[3][8], wv[3][8], bg[8], bv[8];
#pragma unroll
    for (int k = 0; k < 3; ++k)
#pragma unroll
        for (int i = 0; i < 8; ++i) { wg[k][i] = cw[k * FF2 + ch + i]; wv[k][i] = cw[k * FF2 + FF + ch + i]; }
#pragma unroll
    for (int i = 0; i < 8; ++i) { bg[i] = cb[ch + i]; bv[i] = cb[FF + ch + i]; }
    float g2[8], v2[8], g1[8], v1[8];
    unpack8(pg2, g2); unpack8(pv2, v2); unpack8(pg1, g1); unpack8(pv1, v1);
    bf16* p = U + (size_t)row0 * FF2 + ch;
#pragma unroll 4
    for (int r = 0; r < nrows; ++r, p += FF2) {
        const v4u ug = *(const v4u*)p, uv = *(const v4u*)(p + FF);
        float g0[8], v0[8], o[8]; unpack8(ug, g0); unpack8(uv, v0);
#pragma unroll
        for (int i = 0; i < 8; ++i) {
            const float gc = bg[i] + wg[0][i] * g2[i] + wg[1][i] * g1[i] + wg[2][i] * g0[i];
            const float vc = bv[i] + wv[0][i] * v2[i] + wv[1][i] * v1[i] + wv[2][i] * v0[i];
            const float sg = gc * __builtin_amdgcn_rcpf(1.0f + __builtin_amdgcn_exp2f(-1.4426950408889634f * gc));
            o[i] = sg * vc; g2[i] = g1[i]; v2[i] = v1[i]; g1[i] = g0[i]; v1[i] = v0[i];
        }
        v4u w; w.x = pk2(o[0], o[1]); w.y = pk2(o[2], o[3]); w.z = pk2(o[4], o[5]); w.w = pk2(o[6], o[7]);
        *(v4u*)p = w;
    }
}
__device__ __forceinline__ void convgate_phase(bf16* U, const bf16* HALO, const float* cw, const float* cb, int G, int tid) {
    const v4u z = {0u, 0u, 0u, 0u};
    for (int item = blockIdx.x; item < 256; item += G) {
        const int pm = item >> 2, cq = item & 3, rq = tid / 88, cv = tid % 88, ch = 704 * cq + 8 * cv, row0 = 256 * pm + 64 * rq;
        v4u pg2 = z, pv2 = z, pg1 = z, pv1 = z;
        if (tid < 352) {
            const bf16* h2; const bf16* h1;
            if (rq > 0) { h2 = U + (size_t)(row0 - 2) * FF2; h1 = h2 + FF2; }
            else { const int slot = (pm % 16 == 0) ? 64 : pm - 1; h2 = HALO + (size_t)slot * 2 * FF2; h1 = h2 + FF2; }
            pg2 = *(const v4u*)(h2 + ch); pv2 = *(const v4u*)(h2 + FF + ch); pg1 = *(const v4u*)(h1 + ch); pv1 = *(const v4u*)(h1 + FF + ch);
        }
        __syncthreads();
        if (tid < 352) convgate_walk(U, row0, 64, ch, cw, cb, pg2, pv2, pg1, pv1);
        __syncthreads();
    }
    if (blockIdx.x == G - 1 && tid < 352) convgate_walk(U, MROW, 16, 8 * tid, cw, cb, z, z, z, z);
}
__device__ __forceinline__ void attn_simple(const bf16* Q, const bf16* K, const bf16* V, bf16* O, int G, int tid) {
    const int total = NB * NH * T + NH * NMETA;
    for (int base = blockIdx.x * NTHREADS; base < total; base += G * NTHREADS) {
        const int idx = base + tid; const bool valid = idx < total;
        int b = 0, h = 0, npos = 0; size_t qrow = 0;
        if (valid) { if (idx < NB * NH * T) { b = idx / (NH * T); h = (idx / T) % NH; const int t = idx % T; qrow = (size_t)b * T + t; npos = NMETA + t; }
                     else { const int mi = idx - NB * NH * T; h = mi / NMETA; const int t = mi % NMETA; qrow = (size_t)MROW + t; npos = t; } }
        float q[64], o[64];
#pragma unroll
        for (int c = 0; c < 8; ++c) { const v4u w = *(const v4u*)(Q + qrow * D + h * HD + 8 * c); float f[8]; unpack8(w, f);
#pragma unroll
            for (int i = 0; i < 8; ++i) { q[8 * c + i] = f[i]; o[8 * c + i] = 0.f; } }
        int pmax = npos;
#pragma unroll
        for (int s = 1; s < 64; s <<= 1) { const int other = __shfl_xor(pmax, s); pmax = other > pmax ? other : pmax; }
        float carry = 1.f;
        for (int p = pmax - 1; p >= 0; --p) {
            const size_t krow = (p >= NMETA) ? ((size_t)b * T + (p - NMETA)) : (size_t)(MROW + p);
            const bf16* kp = K + krow * D + h * HD; const bf16* vp = V + krow * D + h * HD;
            float z = 0.f;
#pragma unroll
            for (int c = 0; c < 8; ++c) { const v4u w = *(const v4u*)(kp + 8 * c); float f[8]; unpack8(w, f);
#pragma unroll
                for (int i = 0; i < 8; ++i) z += q[8 * c + i] * f[i]; }
            z = fminf(fmaxf(z, -80.f), 80.f);
            const float e = __builtin_amdgcn_exp2f(-z), r = __builtin_amdgcn_rcpf(1.0f + e);
            const bool act = p < npos;
            const float a = act ? r * carry : 0.f; carry = act ? carry * (e * r) : carry;
#pragma unroll
            for (int c = 0; c < 8; ++c) { const v4u w = *(const v4u*)(vp + 8 * c); float f[8]; unpack8(w, f);
#pragma unroll
                for (int i = 0; i < 8; ++i) o[8 * c + i] += a * f[i]; }
        }
        if (valid) {
#pragma unroll
            for (int c = 0; c < 8; ++c) { v4u w; w.x = pk2(o[8 * c], o[8 * c + 1]); w.y = pk2(o[8 * c + 2], o[8 * c + 3]); w.z = pk2(o[8 * c + 4], o[8 * c + 5]); w.w = pk2(o[8 * c + 6], o[8 * c + 7]);
                *(v4u*)(O + qrow * D + h * HD + 8 * c) = w; }
        }
    }
}

struct Args { const float* in[15]; float* out; unsigned char* ws; int ph_lo, ph_hi; };
__global__ void __launch_bounds__(NTHREADS, 2) yoco_fwd(Args args) {
    extern __shared__ __attribute__((aligned(16))) unsigned char lds_raw[];
    LAS unsigned char* lds = (LAS unsigned char*)lds_raw;
    cg::grid_group grid = cg::this_grid();
    const int tid = threadIdx.x, lane = tid & 63, wave = __builtin_amdgcn_readfirstlane(tid >> 6);
    const int G = gridDim.x, bx = blockIdx.x;
    const int gw = bx * NWAVES + wave, NGW = G * NWAVES;
    const int tw = (G - 1 - bx) * NWAVES + wave;
    const float* x = args.in[0]; const float* meta = args.in[1]; const float* mix_norm = args.in[2]; const float* ffn_norm = args.in[3];
    const float* pool_w = args.in[4]; const float* pool_scale = args.in[5]; const float* kv_norm = args.in[6]; const float* w_kv = args.in[7];
    const float* w_q = args.in[8]; const float* w_o = args.in[9]; const float* w_up = args.in[10]; const float* conv_w = args.in[11];
    const float* conv_b = args.in[12]; const float* w_down = args.in[13]; const float* final_norm = args.in[14];
    float* out = args.out; unsigned char* ws = args.ws;
    bf16* Wpool_t = (bf16*)(ws + WS_WPOOL); bf16* Wup_t = (bf16*)(ws + WS_WUP); bf16* Wdown_t = (bf16*)(ws + WS_WDOWN); bf16* Wqkv_t = (bf16*)(ws + WS_WQKV); bf16* Wo_t = (bf16*)(ws + WS_WO);
    bf16* HB = (bf16*)(ws + WS_HB); bf16* U = (bf16*)(ws + WS_U); bf16* HALO = (bf16*)(ws + WS_HALO);
    bf16* DIFF = U; bf16* QB = U; bf16* KB = (bf16*)(ws + WS_U + ACT_BYTES); bf16* VB = (bf16*)(ws + WS_U + 2 * ACT_BYTES); bf16* OB = (bf16*)(ws + WS_U + 3 * ACT_BYTES);
    float* SSQ = (float*)(ws + WS_SSQ); float* HM = (float*)(ws + WS_HM);
    float* ssq1 = SSQ, *ssq2 = SSQ + MR, *ssq3 = SSQ + 2 * MR, *ssq4 = SSQ + 3 * MR;
    const int lo = args.ph_lo, hi = args.ph_hi;
#define IN(k) (lo <= (k) && (k) < hi)
#define SEAM(k) do { if (IN(k) && IN((k) + 1)) grid.sync(); } while (0)

    if (IN(0)) {
        LAS float* scr = (LAS float*)(lds + wave * 16384);
        constexpr int I_POOL = 4 * 32, I_UP = (D / 64) * (FF2 / 32), I_DOWN = (FF / 64) * (D / 32), I_Q = (D / 64) * (D / 32), I_KV = (D / 64) * (2 * D / 32), I_O = I_Q;
        constexpr int NITEMS = I_POOL + 2 * I_UP + 2 * I_DOWN + I_Q + I_KV + I_O;
        for (int it = gw; it < NITEMS; it += NGW) {
            int r = it;
            if (r < I_POOL) { const int g = r / 32; p0_transpose_item(pool_w + (size_t)g * 65536, 256, 256, Wpool_t, 256 * g, nullptr, scr, r % 32, lane); continue; } r -= I_POOL;
            if (r < 2 * I_UP) { const int l = r / I_UP; p0_transpose_item(w_up + (size_t)l * D * FF2, D, FF2, Wup_t + (size_t)l * FF2 * D, 0, ffn_norm + l * D, scr, r % I_UP, lane); continue; } r -= 2 * I_UP;
            if (r < 2 * I_DOWN) { const int l = r / I_DOWN; p0_transpose_item(w_down + (size_t)l * FF * D, FF, D, Wdown_t + (size_t)l * D * FF, 0, nullptr, scr, r % I_DOWN, lane); continue; } r -= 2 * I_DOWN;
            if (r < I_Q) { p0_transpose_item(w_q, D, D, Wqkv_t, 0, mix_norm + D, scr, r, lane); continue; } r -= I_Q;
            if (r < I_KV) { p0_transpose_item(w_kv, D, 2 * D, Wqkv_t, D, kv_norm, scr, r, lane); continue; } r -= I_KV;
            p0_transpose_item(w_o, D, D, Wo_t, 0, nullptr, scr, r, lane);
        }
        for (int c = NGW - 1 - gw; c < M / 16 + 1; c += NGW) {
            if (c < M / 16) p0_diff_chunk<false>(x, meta, mix_norm, DIFF, c / (T / 16), (c % (T / 16)) * 16, lane, scr);
            else p0_diff_chunk<true>(x, meta, mix_norm, DIFF, 0, 0, lane, scr);
        }
        for (int i = bx * NTHREADS + tid; i < 4 * MR; i += G * NTHREADS) SSQ[i] = 0.f;
    }
    SEAM(0);
    if (IN(1)) {
        pg8::Gemm g{DIFF, Wpool_t, M, D, 256, D, 256}; pg8::StaticOrder S; S.init(M, D, G, bx);
        pg8::EpiRes E{x, out, HB, ssq1, pool_scale, D};
        pg8::gemm_phase<pg8::EpiRes, pg8::StaticOrder, false, true>(lds, g, S, E);
        for (int it = tw; it < D / 16; it += NGW) { const int n0 = it * 16, gsel = n0 / 256;
            thin_item(DIFF + (size_t)MROW * D + 256 * gsel, D, Wpool_t, 256, n0, lane, [&](int row4, int col, const f32x4 acc) { thin_res_epi(meta, HM, HB, ssq1, pool_scale, row4, col, acc); }); }
    }
    SEAM(1);
#define FFN_PHASES(l, pb, ssq_in, ssq_out) do { \
          \
        if (IN(pb)) { \
            const bf16* Wt = Wup_t + (size_t)(l) * FF2 * D; \
            pg8::Gemm g{HB, Wt, M, FF2, D, D, 0}; pg8::StaticOrder S; S.init(M, FF2, G, bx); \
            pg8::EpiRsBf16 E{U, FF2, ssq_in, 0, 0, 1.f, HALO}; \
            pg8::gemm_phase<pg8::EpiRsBf16, pg8::StaticOrder, true, true>(lds, g, S, E); \
            for (int it = tw; it < FF2 / 16; it += NGW) \
                thin_item(HB + (size_t)MROW * D, D, Wt, D, it * 16, lane, [&](int row4, int col, const f32x4 acc) { \
                    _Pragma("unroll") \
                    for (int i = 0; i < 4; ++i) { const int r = row4 + i; const bf16 v = (bf16)(pk2(acc[i] * rs_of(ssq_in[MROW + r]), 0.f) & 0xffffu); \
                        U[(size_t)(MROW + r) * FF2 + col] = v; if (r >= 14) HALO[(size_t)(64 * 2 + (r - 14)) * FF2 + col] = v; } }); \
        } \
        SEAM(pb); \
          \
        if (IN(pb + 1)) convgate_phase(U, HALO, conv_w + (size_t)(l) * 3 * FF2, conv_b + (size_t)(l) * FF2, G, tid); \
        SEAM(pb + 1); \
          \
        if (IN(pb + 2)) { \
            const bf16* Wt = Wdown_t + (size_t)(l) * D * FF; \
            pg8::Gemm g{U, Wt, M, D, FF, FF2, 0}; pg8::StaticOrder S; S.init(M, D, G, bx); \
            pg8::EpiRes E{out, out, ((l) == 0) ? HB : nullptr, ssq_out, nullptr, D}; \
            pg8::gemm_phase<pg8::EpiRes, pg8::StaticOrder, false, true>(lds, g, S, E); \
            if ((l) == 0) \
                for (int it = tw; it < D / 16; it += NGW) \
                    thin_item(U + (size_t)MROW * FF2, FF2, Wt, FF, it * 16, lane, [&](int row4, int col, const f32x4 acc) { thin_res_epi(HM, HM, HB, ssq_out, nullptr, row4, col, acc); }); \
        } \
        SEAM(pb + 2); } while (0)
    FFN_PHASES(0, 2, ssq1, ssq2);
    if (IN(5)) {
        pg8::Gemm g{HB, Wqkv_t, M, 3 * D, D, D, 0}; pg8::StaticOrder S; S.init(M, 3 * D, G, bx);
        pg8::EpiRsBf16 E{QB, D, ssq2, D, ACT_BYTES / 2, C2, nullptr};
        pg8::gemm_phase<pg8::EpiRsBf16, pg8::StaticOrder, true, true>(lds, g, S, E);
        for (int it = tw; it < 3 * D / 16; it += NGW)
            thin_item(HB + (size_t)MROW * D, D, Wqkv_t, D, it * 16, lane, [&](int row4, int col, const f32x4 acc) {
                const int tsel = col / D, cc = col % D; bf16* dst = QB + (size_t)tsel * (ACT_BYTES / 2);
#pragma unroll
                for (int i = 0; i < 4; ++i) { const int r = row4 + i; const float v = acc[i] * rs_of(ssq2[MROW + r]) * (tsel == 0 ? C2 : 1.f); dst[(size_t)(MROW + r) * D + cc] = (bf16)(pk2(v, 0.f) & 0xffffu); } });
        for (int i = bx * NTHREADS + tid; i < 2 * 48 * D / 8; i += G * NTHREADS) { const int which = i / (48 * D / 8), off = i % (48 * D / 8);
            *(v4u*)((which ? VB : KB) + (size_t)(MROW + 16) * D + (size_t)off * 8) = (v4u){0u, 0u, 0u, 0u}; }
    }
    SEAM(5);
    if (IN(6)) {
#if ATTN_SIMPLE
        attn_simple(QB, KB, VB, OB, G, tid);
#else
        sb_attn_phase((char*)lds_raw, QB, KB, VB, OB, G, bx);
#endif
    }
    SEAM(6);
    if (IN(7)) {
        pg8::Gemm g{OB, Wo_t, M, D, D, D, 0}; pg8::StaticOrder S; S.init(M, D, G, bx);
        pg8::EpiRes E{out, out, HB, ssq3, nullptr, D};
        pg8::gemm_phase<pg8::EpiRes, pg8::StaticOrder, false, true>(lds, g, S, E);
        for (int it = tw; it < D / 16; it += NGW)
            thin_item(OB + (size_t)MROW * D, D, Wo_t, D, it * 16, lane, [&](int row4, int col, const f32x4 acc) { thin_res_epi(HM, HM, HB, ssq3, nullptr, row4, col, acc); });
    }
    SEAM(7);
    FFN_PHASES(1, 8, ssq3, ssq4);
#undef FFN_PHASES
    if (IN(11)) {
        f32x4 gv[4];
#pragma unroll
        for (int j = 0; j < 4; ++j) gv[j] = *(const f32x4*)(final_norm + 4 * lane + 256 * j);
        for (int r = gw; r < M; r += NGW) { const float rs = rs_of(ssq4[r]); float* p = out + (size_t)r * D + 4 * lane;
#pragma unroll
            for (int j = 0; j < 4; ++j) { const f32x4 v = *(const f32x4*)(p + 256 * j); *(f32x4*)(p + 256 * j) = v * rs * gv[j]; } }
    }
#undef IN
#undef SEAM
}

extern "C" void kernel_launch(void* const* d_in, const int* in_sizes, int n_in, void* d_out, int out_size, void* d_ws, size_t ws_size, hipStream_t stream) {
    static int grid = 0;
    if (grid == 0) {
        if (n_in != 15 || in_sizes[0] != M * D || out_size != M * D || ws_size < WS_END) { fprintf(stderr, "kernel_launch: unexpected shapes (n_in %d, in0 %d, out %d, ws %zu, need %zu); nothing launched\n", n_in, n_in > 0 ? in_sizes[0] : -1, out_size, ws_size, (size_t)WS_END); grid = -1; return; }
        int dev = 0, cus = 0, per_cu = 0;
        if (hipGetDevice(&dev) != hipSuccess || hipDeviceGetAttribute(&cus, hipDeviceAttributeMultiprocessorCount, dev) != hipSuccess) { grid = -1; return; }
        if (hipFuncSetAttribute((const void*)yoco_fwd, hipFuncAttributeMaxDynamicSharedMemorySize, LDS_BYTES) != hipSuccess) { fprintf(stderr, "kernel_launch: hipFuncSetAttribute failed\n"); grid = -1; return; }
        if (hipOccupancyMaxActiveBlocksPerMultiprocessor(&per_cu, (const void*)yoco_fwd, NTHREADS, LDS_BYTES) != hipSuccess || per_cu < 1) per_cu = 1;
        (void)hipGetLastError();
        grid = cus * per_cu;
    }
    if (grid < 0) return;
    Args a{};
    for (int i = 0; i < 15; ++i) a.in[i] = (const float*)d_in[i];
    a.out = (float*)d_out; a.ws = (unsigned char*)d_ws;
#if MK_N_LAUNCHES == 1
    a.ph_lo = 0; a.ph_hi = NPHASES;
    void* kargs[] = {&a};
    hipError_t e = hipLaunchCooperativeKernel((const void*)yoco_fwd, dim3(grid), dim3(NTHREADS), kargs, LDS_BYTES, stream);
    if (e != hipSuccess) fprintf(stderr, "kernel_launch: cooperative launch failed: %s (grid %d)\n", hipGetErrorString(e), grid);
#else
    for (int p = 0; p < NPHASES; ++p) { a.ph_lo = p; a.ph_hi = p + 1; hipLaunchKernelGGL(yoco_fwd, dim3(grid), dim3(NTHREADS), LDS_BYTES, stream, a); }
#endif
}
```

```cpp
#include <hip/hip_runtime.h>
#include <hip/hip_cooperative_groups.h>
#include <cstdio>
#include <cstdint>
namespace cg = cooperative_groups;
namespace pg8 {
#define PG8_LAS __attribute__((address_space(3)))
typedef unsigned short bf16_t;
typedef short bf16x8 __attribute__((ext_vector_type(8)));
typedef float f32x4 __attribute__((ext_vector_type(4)));
typedef unsigned u32x4 __attribute__((ext_vector_type(4)));
constexpr int BM = 256, BK = 64, HALF = 128, HTB = HALF * BK * 2  , STAGE_BYTES = 8 * HTB, NXCD = 8, WGM = 8;

__host__ __device__ __forceinline__ int lds_byte(int r, int c) { const int st = (r >> 4) * 2 + (c >> 5), rr = r & 15, cc = c & 31, ob = rr * 64 + cc * 2; return st * 1024 + (ob ^ (((ob >> 9) & 1) << 5)); }
__host__ __device__ __forceinline__ void stage_rc(int b, int& R, int& C) { const int st = b / 1024, sb = b % 1024, swz = sb ^ (((sb >> 9) & 1) << 5); R = (st >> 1) * 16 + swz / 64; C = (st & 1) * 32 + (swz % 64) / 2; }
__host__ __device__ __forceinline__ int perm32(int rho) { const int n = rho >> 4, i = rho & 15; return 8 * (i >> 2) + 4 * n + (i & 3); }

struct Unit { int pm, pn; };
struct Gemm { const bf16_t* A; const bf16_t* Bt; int M, N, K, lda, acs; };

struct StaticOrder {
    int nM, nN, nwg, G, c;
    __host__ __device__ void init(int M, int N, int G_, int c_) { nM = M / BM; nN = N / BM; nwg = nM * nN; G = G_; c = c_; }
    __host__ __device__ bool next(int i, Unit& u) const {
        const long L = (long)i * G + c; if (L >= nwg) return false;
        int wgid = (int)L; { const int q = nwg / NXCD, r = nwg % NXCD, xcd = wgid % NXCD, off = wgid / NXCD; wgid = (xcd < r ? xcd * (q + 1) : r * (q + 1) + (xcd - r) * q) + off; }
        const int nig = WGM * nN, gid = wgid / nig, fm = gid * WGM, gsz = (nM - fm) < WGM ? (nM - fm) : WGM;
        u.pm = fm + ((wgid % nig) % gsz); u.pn = (wgid % nig) / gsz; return true;
    }
    __device__ __forceinline__ void a_ready(const Unit&) const {}
    __device__ __forceinline__ void done(const Unit&) const {}
};

__device__ __forceinline__ unsigned cvt_pk_bf16(float lo, float hi) { unsigned r; asm volatile("v_cvt_pk_bf16_f32 %0, %1, %2" : "=v"(r) : "v"(lo), "v"(hi)); return r; }
typedef unsigned u32x2 __attribute__((ext_vector_type(2)));
constexpr float RMS_EPS_C = 1e-6f;
struct EpiRsBf16 {
    static constexpr bool PERM = true, AFTER_DRAIN = false;
    bf16_t* O; int ldc; const float* ssq; int split_cols; size_t split_stride; float scale0; bf16_t* halo;
    __device__ __forceinline__ void operator()(const f32x4 (&acc)[2][2][4][2], const Unit& u, int wr, int wc, int fr, int fq) const {
        const int row0 = u.pm * BM + wr * 64 + fr; int colt = u.pn * BM; bf16_t* base = O;
        float sc = 1.f; if (split_cols) { const int t = colt / split_cols; base += (size_t)t * split_stride; colt -= t * split_cols; if (t == 0) sc = scale0; }
        const int col0 = colt + wc * 32 + 8 * fq;
#pragma unroll
        for (int ai = 0; ai < 2; ++ai)
#pragma unroll
            for (int m = 0; m < 4; ++m) { const int row = row0 + ai * HALF + m * 16; const float rs = __builtin_amdgcn_rsqf(ssq[row] * (1.0f / 1024.0f) + RMS_EPS_C) * sc;
                bf16_t* rowp = base + (size_t)row * ldc + col0;
#pragma unroll
                for (int bj = 0; bj < 2; ++bj) { const f32x4 v0 = acc[ai][bj][m][0] * rs, v1 = acc[ai][bj][m][1] * rs;
                    u32x4 w; w.x = cvt_pk_bf16(v0[0], v0[1]); w.y = cvt_pk_bf16(v0[2], v0[3]); w.z = cvt_pk_bf16(v1[0], v1[1]); w.w = cvt_pk_bf16(v1[2], v1[3]);
                    *(u32x4*)(rowp + bj * HALF) = w;
                    if (halo != nullptr && ai == 1 && m == 3 && wr == 1 && fr >= 14) *(u32x4*)(halo + (size_t)(u.pm * 2 + (fr - 14)) * ldc + col0 + bj * HALF) = w; } }
    }
};
struct EpiRes {
    static constexpr bool PERM = false, AFTER_DRAIN = false;
    const float* base; float* out; bf16_t* hb; float* ssq; const float* cscale; int ldc;
    __device__ __forceinline__ void operator()(const f32x4 (&acc)[2][2][4][2], const Unit& u, int wr, int wc, int fr, int fq) const {
        const int col0 = u.pn * BM + wc * 32 + 4 * fq;
        f32x4 cs[2][2];
#pragma unroll
        for (int bj = 0; bj < 2; ++bj)
#pragma unroll
            for (int n = 0; n < 2; ++n) cs[bj][n] = cscale ? *(const f32x4*)(cscale + col0 + bj * HALF + n * 16) : (f32x4){1.f, 1.f, 1.f, 1.f};
#pragma unroll
        for (int ai = 0; ai < 2; ++ai)
#pragma unroll
            for (int m = 0; m < 4; ++m) { const int r = u.pm * BM + ai * HALF + wr * 64 + m * 16 + fr; const size_t off = (size_t)r * ldc + col0; float q = 0.f;
#pragma unroll
                for (int bj = 0; bj < 2; ++bj)
#pragma unroll
                    for (int n = 0; n < 2; ++n) { const f32x4 bs = *(const f32x4*)(base + off + bj * HALF + n * 16); const f32x4 o = bs + acc[ai][bj][m][n] * cs[bj][n];
                        *(f32x4*)(out + off + bj * HALF + n * 16) = o; q += (o[0] * o[0] + o[1] * o[1]) + (o[2] * o[2] + o[3] * o[3]);
                        if (hb != nullptr) { u32x2 w; w.x = cvt_pk_bf16(o[0], o[1]); w.y = cvt_pk_bf16(o[2], o[3]); *(u32x2*)(hb + off + bj * HALF + n * 16) = w; } }
                q += __shfl_xor(q, 16); q += __shfl_xor(q, 32);
                if (fq == 0) atomicAdd(ssq + r, q);
                if (m & 1) asm volatile("" ::: "memory"); }
    }
};

template <class Epi, class Sched, bool ALIGN_EPI = false, bool SP2 = false>
__device__ __forceinline__ void gemm_phase(PG8_LAS unsigned char* lds, const Gemm g, const Sched& S, const Epi& E) {
    const int tid = threadIdx.x, wid = __builtin_amdgcn_readfirstlane(tid >> 6), lane = tid & 63, wr = wid >> 2, wc = wid & 3, fr = lane & 15, fq = lane >> 4;
    const int K = g.K, nt = K / BK;
    unsigned voffA[2], voffB[2];
#pragma unroll
    for (int i = 0; i < 2; ++i) { int R, C; stage_rc(tid * 16 + i * 8192, R, C); const int Rb = Epi::PERM ? ((R & ~31) + perm32(R & 31)) : R;
        voffA[i] = (unsigned)(R * g.lda + C) * 2u; voffB[i] = (unsigned)(Rb * K + C) * 2u; }
    const size_t kstep = (size_t)(BK * 2);
    const size_t hstepA = (size_t)HALF * g.lda * 2, hstepB = (size_t)HALF * K * 2;
    const size_t tstepA = 2 * hstepA, tstepB = 2 * hstepB; const size_t acsb = (size_t)g.acs * 2;
    const unsigned ldsw = (unsigned)wid * 1024u;
    const int aoff = lds_byte(wr * 64 + fr, fq * 8), boff = lds_byte(wc * 32 + fr, fq * 8);
#define PG8_SA(b, h) (((b) * 2 + (h)) * HTB)
#define PG8_SB(b, h) ((4 + (b) * 2 + (h)) * HTB)
#define PG8_STAGE(bufoff, gbase, voff) do { _Pragma("unroll") for (int _i = 0; _i < 2; ++_i) \
        __builtin_amdgcn_global_load_lds((const unsigned*)((const char*)(gbase) + (voff)[_i]), (PG8_LAS unsigned*)(lds + (bufoff) + ldsw + _i * 8192), 16, 0, 0); } while (0)
#define PG8_LDA(dst, b, h) do { _Pragma("unroll") for (int m = 0; m < 4; ++m) _Pragma("unroll") for (int k = 0; k < 2; ++k) dst[m][k] = *(const PG8_LAS bf16x8*)(lds + PG8_SA(b, h) + aoff + m * 2048 + k * 1024); } while (0)
#define PG8_LDB(dst, b, h) do { _Pragma("unroll") for (int n = 0; n < 2; ++n) _Pragma("unroll") for (int k = 0; k < 2; ++k) dst[n][k] = *(const PG8_LAS bf16x8*)(lds + PG8_SB(b, h) + boff + n * 2048 + k * 1024); } while (0)
#define PG8_MMA(ai, bj, At, Bt) do { __builtin_amdgcn_s_setprio(1); _Pragma("unroll") for (int m = 0; m < 4; ++m) _Pragma("unroll") for (int n = 0; n < 2; ++n) _Pragma("unroll") for (int k = 0; k < 2; ++k) \
        acc[ai][bj][m][n] = __builtin_amdgcn_mfma_f32_16x16x32_bf16(Bt[n][k], At[m][k], acc[ai][bj][m][n], 0, 0, 0); __builtin_amdgcn_s_setprio(0); } while (0)
#define PG8_WAIT_V(n) asm volatile("s_waitcnt vmcnt(" #n ")" ::: "memory")
#define PG8_WAIT_L(n) asm volatile("s_waitcnt lgkmcnt(" #n ")" ::: "memory")
#define PG8_BAR __builtin_amdgcn_s_barrier()
#define PG8_SCHED __builtin_amdgcn_sched_barrier(0)
    Unit cur, nxt; int ui = 0;
    if (!S.next(0, cur)) return;
    f32x4 acc[2][2][4][2];
#pragma unroll
    for (int a = 0; a < 2; ++a)
#pragma unroll
        for (int b = 0; b < 2; ++b)
#pragma unroll
            for (int m = 0; m < 4; ++m)
#pragma unroll
                for (int n = 0; n < 2; ++n) acc[a][b][m][n] = (f32x4){0.f, 0.f, 0.f, 0.f};
    bf16x8 At[4][2], B0[2][2], B1[2][2];
    const char* cA = (const char*)g.A + (size_t)cur.pm * tstepA + (size_t)cur.pn * acsb; const char* cB = (const char*)g.Bt + (size_t)cur.pn * tstepB;
    S.a_ready(cur);
    if constexpr (SP2) {
        PG8_STAGE(PG8_SB(0, 0), cB, voffB); PG8_STAGE(PG8_SB(0, 1), cB + hstepB, voffB); PG8_STAGE(PG8_SA(0, 0), cA, voffA); PG8_STAGE(PG8_SA(0, 1), cA + hstepA, voffA);
        if (wr == 1) PG8_BAR;
        PG8_WAIT_V(2); PG8_BAR;
        PG8_STAGE(PG8_SB(1, 0), cB + kstep, voffB); PG8_STAGE(PG8_SA(1, 0), cA + kstep, voffA); PG8_STAGE(PG8_SB(1, 1), cB + hstepB + kstep, voffB);
        PG8_WAIT_V(6); PG8_BAR;
    } else {
        PG8_STAGE(PG8_SB(0, 0), cB, voffB); PG8_STAGE(PG8_SA(0, 0), cA, voffA); PG8_STAGE(PG8_SB(0, 1), cB + hstepB, voffB); PG8_STAGE(PG8_SA(0, 1), cA + hstepA, voffA);
        if (wr == 1) PG8_BAR;
        PG8_WAIT_V(4); PG8_BAR;
        PG8_STAGE(PG8_SB(1, 0), cB + kstep, voffB); PG8_STAGE(PG8_SA(1, 0), cA + kstep, voffA); PG8_STAGE(PG8_SB(1, 1), cB + hstepB + kstep, voffB);
        PG8_WAIT_V(6); PG8_BAR;
    }
    for (;;) {
        const bool has_next = S.next(ui + 1, nxt);
        const char* nA = has_next ? (const char*)g.A + (size_t)nxt.pm * tstepA + (size_t)nxt.pn * acsb : cA; const char* nB = has_next ? (const char*)g.Bt + (size_t)nxt.pn * tstepB : cB;
        for (int t = 0; t < nt; t += 2) {
            const bool last = (t == nt - 2);
            const char* a1 = cA + (size_t)(t + 1) * kstep;
            const char* a2 = last ? nA : cA + (size_t)(t + 2) * kstep; const char* b2 = last ? nB : cB + (size_t)(t + 2) * kstep;
            const char* a3 = a2 + kstep; const char* b3 = b2 + kstep;
            if (last && has_next) S.a_ready(nxt);
            if constexpr (SP2) {
            PG8_LDB(B0, 0, 0); PG8_LDB(B1, 0, 1); PG8_SCHED; PG8_LDA(At, 0, 0); PG8_STAGE(PG8_SA(1, 1), a1 + hstepA, voffA);
            PG8_WAIT_V(8); PG8_WAIT_L(0); PG8_BAR; PG8_MMA(0, 0, At, B0); PG8_MMA(0, 1, At, B1); PG8_BAR; PG8_SCHED;
            PG8_LDA(At, 0, 1); PG8_STAGE(PG8_SB(0, 0), b2, voffB); PG8_STAGE(PG8_SB(0, 1), b2 + hstepB, voffB); PG8_STAGE(PG8_SA(0, 0), a2, voffA);
            PG8_WAIT_V(8); PG8_WAIT_L(0); PG8_BAR; PG8_MMA(1, 0, At, B0); PG8_MMA(1, 1, At, B1); PG8_BAR; PG8_SCHED;
            PG8_LDB(B0, 1, 0); PG8_LDB(B1, 1, 1); PG8_SCHED; PG8_LDA(At, 1, 0); PG8_STAGE(PG8_SA(0, 1), a2 + hstepA, voffA);
            PG8_WAIT_V(8); PG8_WAIT_L(0); PG8_BAR; PG8_MMA(0, 0, At, B0); PG8_MMA(0, 1, At, B1); PG8_BAR; PG8_SCHED;
            PG8_LDA(At, 1, 1); PG8_STAGE(PG8_SB(1, 0), b3, voffB); PG8_STAGE(PG8_SB(1, 1), b3 + hstepB, voffB); PG8_STAGE(PG8_SA(1, 0), a3, voffA);
            PG8_WAIT_V(8); PG8_WAIT_L(0); PG8_BAR; PG8_MMA(1, 0, At, B0); PG8_MMA(1, 1, At, B1); PG8_BAR; PG8_SCHED;
            } else {
            PG8_LDB(B0, 0, 0); PG8_SCHED; PG8_LDA(At, 0, 0); PG8_STAGE(PG8_SA(1, 1), a1 + hstepA, voffA);
            PG8_WAIT_L(8); PG8_BAR; PG8_WAIT_L(0); PG8_MMA(0, 0, At, B0); PG8_BAR; PG8_SCHED;
            PG8_LDB(B1, 0, 1); PG8_STAGE(PG8_SB(0, 0), b2, voffB);
            PG8_BAR; PG8_WAIT_L(0); PG8_MMA(0, 1, At, B1); PG8_BAR;
            PG8_LDA(At, 0, 1); PG8_STAGE(PG8_SA(0, 0), a2, voffA);
            PG8_BAR; PG8_WAIT_L(0); PG8_MMA(1, 0, At, B0); PG8_BAR; PG8_SCHED;
            PG8_STAGE(PG8_SB(0, 1), b2 + hstepB, voffB);
            PG8_WAIT_V(6); PG8_BAR; PG8_MMA(1, 1, At, B1); PG8_BAR;
            PG8_LDB(B0, 1, 0); PG8_SCHED; PG8_LDA(At, 1, 0); PG8_STAGE(PG8_SA(0, 1), a2 + hstepA, voffA);
            PG8_WAIT_L(8); PG8_BAR; PG8_WAIT_L(0); PG8_MMA(0, 0, At, B0); PG8_BAR; PG8_SCHED;
            PG8_LDB(B1, 1, 1); PG8_STAGE(PG8_SB(1, 0), b3, voffB);
            PG8_BAR; PG8_WAIT_L(0); PG8_MMA(0, 1, At, B1); PG8_BAR;
            PG8_LDA(At, 1, 1); PG8_STAGE(PG8_SA(1, 0), a3, voffA);
            PG8_BAR; PG8_WAIT_L(0); PG8_MMA(1, 0, At, B0); PG8_BAR; PG8_SCHED;
            PG8_STAGE(PG8_SB(1, 1), b3 + hstepB, voffB);
            PG8_WAIT_V(6); PG8_BAR; PG8_MMA(1, 1, At, B1); PG8_BAR;
            }
        }
        if constexpr (ALIGN_EPI) { if (wr == 0) PG8_BAR; }
        if constexpr (!Epi::AFTER_DRAIN) { E(acc, cur, wr, wc, fr, fq); S.done(cur); }
        if (!has_next) break;
#pragma unroll
        for (int a = 0; a < 2; ++a)
#pragma unroll
            for (int b = 0; b < 2; ++b)
#pragma unroll
                for (int m = 0; m < 4; ++m)
#pragma unroll
                    for (int n = 0; n < 2; ++n) acc[a][b][m][n] = (f32x4){0.f, 0.f, 0.f, 0.f};
        cur = nxt; cA = nA; cB = nB; ++ui;
        if constexpr (ALIGN_EPI) { if (wr == 1) PG8_BAR; }
    }
    PG8_WAIT_V(0);
    if constexpr (!ALIGN_EPI) { if (wr == 0) PG8_BAR; }
    PG8_BAR;
    if constexpr (Epi::AFTER_DRAIN) { E.fused(acc, cur, wr, wc, fr, fq, lds, wid, lane); S.done(cur); }
#undef PG8_SA
#undef PG8_SB
#undef PG8_STAGE
#undef PG8_LDA
#undef PG8_LDB
#undef PG8_MMA
#undef PG8_WAIT_V
#undef PG8_WAIT_L
#undef PG8_BAR
#undef PG8_SCHED
}
}
namespace sba {
#define SBA_LAS __attribute__((address_space(3)))
typedef unsigned short bf16;
using bf16x8 = __attribute__((ext_vector_type(8))) short;
using s16x4 = __attribute__((ext_vector_type(4))) short;
using f32x16 = __attribute__((ext_vector_type(16))) float;
using u32x4 = __attribute__((ext_vector_type(4))) unsigned;
constexpr int AT = 4096, AD = 1024, AMROW = 16384;
constexpr int SLOTB = 8192, LDS_K = 0, LDS_V = 3 * SLOTB, LDS_OST = 6 * SLOTB;
__device__ __forceinline__ int crow(int r, int hi) { return (r & 3) + 8 * (r >> 2) + 4 * hi; }
__device__ __forceinline__ void glds16(const void* gsrc, unsigned lds_dst) { unsigned keep;
    asm volatile("s_mov_b32 %0, m0\n\ts_mov_b32 m0, %2\n\ts_nop 0\n\tglobal_load_lds_dwordx4 %1, off\n\ts_mov_b32 m0, %0" : "=&s"(keep) : "v"(gsrc), "s"(lds_dst) : "memory"); }
typedef float f32x2_t __attribute__((ext_vector_type(2))); typedef __bf16 bf16x2_t __attribute__((ext_vector_type(2)));
__device__ __forceinline__ unsigned cvtpk_s(float lo, float hi) { f32x2_t v = {lo, hi}; bf16x2_t b = __builtin_convertvector(v, bf16x2_t); return __builtin_bit_cast(unsigned, b); }
#define SBA_WAIT_BAR(N) asm volatile("s_waitcnt vmcnt(" #N ") lgkmcnt(0)\n\ts_barrier" ::: "memory")
__device__ __forceinline__ void pv(f32x16* o, int vb, bf16x8 pa0, bf16x8 pa1, bf16x8 pa2, bf16x8 pa3) {
#pragma unroll
    for (int d0 = 0; d0 < 2; ++d0) { s16x4 lo[4], hi[4];
#pragma unroll
        for (int ks = 0; ks < 4; ++ks) {
            asm volatile("ds_read_b64_tr_b16 %0,%1 offset:%c2" : "=&v"(lo[ks]) : "v"(vb), "i"(d0 * 4096 + ks * 1024) : "memory");
            asm volatile("ds_read_b64_tr_b16 %0,%1 offset:%c2" : "=&v"(hi[ks]) : "v"(vb), "i"(d0 * 4096 + ks * 1024 + 512) : "memory"); }
        asm volatile("s_waitcnt lgkmcnt(0)" ::: "memory"); __builtin_amdgcn_sched_barrier(0);
#define SBA_PK(k) (bf16x8){lo[k][0], lo[k][1], lo[k][2], lo[k][3], hi[k][0], hi[k][1], hi[k][2], hi[k][3]}
        o[d0] = __builtin_amdgcn_mfma_f32_32x32x16_bf16(pa0, SBA_PK(0), o[d0], 0, 0, 0);
        o[d0] = __builtin_amdgcn_mfma_f32_32x32x16_bf16(pa1, SBA_PK(1), o[d0], 0, 0, 0);
        o[d0] = __builtin_amdgcn_mfma_f32_32x32x16_bf16(pa2, SBA_PK(2), o[d0], 0, 0, 0);
        o[d0] = __builtin_amdgcn_mfma_f32_32x32x16_bf16(pa3, SBA_PK(3), o[d0], 0, 0, 0);
#undef SBA_PK
    }
}
template <bool MASK>
__device__ __forceinline__ void tile(f32x16 (&o)[2], float& R, const bf16x8 (&qr)[4], SBA_LAS const unsigned char* kslot, int vb, int r32, int hi, int lim) {
    SBA_LAS const unsigned char* kb = kslot + hi * 1024 + r32 * 16;
    f32x16 p0 = {}, p1 = {};
#pragma unroll
    for (int d0 = 0; d0 < 4; ++d0) {
        const bf16x8 b0 = *(SBA_LAS const bf16x8*)(kb + d0 * 2048);
        const bf16x8 b1 = *(SBA_LAS const bf16x8*)(kb + d0 * 2048 + 512);
        p0 = __builtin_amdgcn_mfma_f32_32x32x16_bf16(b0, qr[d0], p0, 0, 0, 0);
        p1 = __builtin_amdgcn_mfma_f32_32x32x16_bf16(b1, qr[d0], p1, 0, 0, 0);
    }
    f32x16 m0, m1;
    const int limh = lim - 4 * hi;
#pragma unroll
    for (int r = 0; r < 16; ++r) {
        float b0 = __builtin_amdgcn_rcpf(1.0f + __builtin_amdgcn_exp2f(-p0[r])), b1 = __builtin_amdgcn_rcpf(1.0f + __builtin_amdgcn_exp2f(-p1[r]));
        if (MASK) { const int kv = (r & 3) + 8 * (r >> 2); b0 = (kv < limh) ? b0 : 0.f; b1 = (kv + 32 < limh) ? b1 : 0.f; }
        p0[r] = b0; p1[r] = b1; m0[r] = 1.0f - b0; m1[r] = 1.0f - b1;
    }
    float tl[8], th[8];
#pragma unroll
    for (int I = 0; I < 8; ++I) {
        const float t = (I < 4) ? (m0[4 * I] * m0[4 * I + 1]) * (m0[4 * I + 2] * m0[4 * I + 3]) : (m1[4 * I - 16] * m1[4 * I - 15]) * (m1[4 * I - 14] * m1[4 * I - 13]);
        auto rr = __builtin_amdgcn_permlane32_swap(__float_as_uint(t), __float_as_uint(t), false, false);
        tl[I] = __uint_as_float(rr[0]); th[I] = __uint_as_float(rr[1]);
    }
#pragma unroll
    for (int I = 7; I >= 0; --I) {
        float E = R * (hi ? 1.0f : th[I]);
        if (I < 4) { p0[4 * I + 3] *= E; E *= m0[4 * I + 3]; p0[4 * I + 2] *= E; E *= m0[4 * I + 2]; p0[4 * I + 1] *= E; E *= m0[4 * I + 1]; p0[4 * I] *= E; }
        else { const int q = 4 * I - 16; p1[q + 3] *= E; E *= m1[q + 3]; p1[q + 2] *= E; E *= m1[q + 2]; p1[q + 1] *= E; E *= m1[q + 1]; p1[q] *= E; }
        R *= tl[I] * th[I];
    }
    u32x4 pw0, pw1, pw2, pw3;
    pw0 = (u32x4){cvtpk_s(p0[0], p0[1]), cvtpk_s(p0[2], p0[3]), cvtpk_s(p0[4], p0[5]), cvtpk_s(p0[6], p0[7])};
    pw1 = (u32x4){cvtpk_s(p0[8], p0[9]), cvtpk_s(p0[10], p0[11]), cvtpk_s(p0[12], p0[13]), cvtpk_s(p0[14], p0[15])};
    pw2 = (u32x4){cvtpk_s(p1[0], p1[1]), cvtpk_s(p1[2], p1[3]), cvtpk_s(p1[4], p1[5]), cvtpk_s(p1[6], p1[7])};
    pw3 = (u32x4){cvtpk_s(p1[8], p1[9]), cvtpk_s(p1[10], p1[11]), cvtpk_s(p1[12], p1[13]), cvtpk_s(p1[14], p1[15])};
    __builtin_amdgcn_sched_barrier(0);
    pv(o, vb, __builtin_bit_cast(bf16x8, pw0), __builtin_bit_cast(bf16x8, pw1), __builtin_bit_cast(bf16x8, pw2), __builtin_bit_cast(bf16x8, pw3));
}
__device__ __forceinline__ void unit(int b, int h, int qb, const bf16* Q, const bf16* __restrict__ K, const bf16* __restrict__ V, bf16* O, SBA_LAS unsigned char* shm) {
    const int tid = threadIdx.x, lane = tid & 63, r32 = lane & 31, hi = lane >> 5; const int wid = __builtin_amdgcn_readfirstlane(tid >> 6);
    const size_t rowbase = (size_t)b * AT; const int q0 = qb * 256;
    const bf16* Qw = Q + (rowbase + q0 + wid * 32) * AD + h * 64;
    const unsigned lds0 = (unsigned)(uintptr_t)shm;
    const bf16* ksrc = K + h * 64 + (size_t)lane * AD + wid * 8;
    const bf16* vsrc = V + h * 64 + (size_t)(16 * (wid & 3) + (lane >> 2)) * AD + (wid >> 2) * 32 + (lane & 3) * 8;
    const unsigned kdst = lds0 + LDS_K + wid * 1024, vdst = lds0 + LDS_V + wid * 1024;
    const int NTr = 4 * (qb + 1), NT = NTr + 1;
#define SBA_TROW(it) ((it) < NTr ? rowbase + (size_t)(NTr - 1 - (it)) * 64 : (size_t)AMROW)
#define SBA_DMA(it, sl) do { const size_t tr_ = SBA_TROW(it); glds16(ksrc + tr_ * AD, (unsigned)__builtin_amdgcn_readfirstlane(kdst + (sl) * SLOTB)); glds16(vsrc + tr_ * AD, (unsigned)__builtin_amdgcn_readfirstlane(vdst + (sl) * SLOTB)); } while (0)
    bf16x8 qr[4];
#pragma unroll
    for (int d0 = 0; d0 < 4; ++d0) qr[d0] = *(const bf16x8*)(Qw + (size_t)r32 * AD + d0 * 16 + hi * 8);
    SBA_DMA(0, 0); SBA_DMA(1, 1);
    f32x16 o[2]; o[0] = f32x16{}; o[1] = f32x16{};
    float R = 1.0f;
    const int tmin = q0 + wid * 32, tmax = tmin + 31, tq = tmin + r32;
    const int vb0 = (int)(lds0 + LDS_V) + ((lane >> 4) & 1) * 32 + (lane & 3) * 8 + (4 * hi + ((lane & 15) >> 2)) * 64;
    int sl = 0;
    for (int it = 0; it < NT; ++it) {
        if (it + 1 < NT) SBA_WAIT_BAR(2); else SBA_WAIT_BAR(0);
        if (it + 2 < NT) { const int s2 = (sl >= 1) ? sl - 1 : 2; SBA_DMA(it + 2, s2); }
        const bool is_meta = it >= NTr; const int k0 = 64 * (NTr - 1 - it);
        if (is_meta || k0 < tmax) {
            SBA_LAS const unsigned char* kslot = shm + LDS_K + sl * SLOTB; const int vb = vb0 + sl * SLOTB;
            if (is_meta) tile<true>(o, R, qr, kslot, vb, r32, hi, 16);
            else if (k0 + 63 >= tmin) tile<true>(o, R, qr, kslot, vb, r32, hi, tq - k0);
            else tile<false>(o, R, qr, kslot, vb, r32, hi, 64);
        }
        sl = (sl == 2) ? 0 : sl + 1;
    }
    bf16* Ow = O + (rowbase + q0 + wid * 32) * AD + h * 64;
    { SBA_LAS bf16* stg = (SBA_LAS bf16*)(shm + LDS_OST) + wid * 2048;
#pragma unroll
      for (int r = 0; r < 16; ++r) { const int orow = crow(r, hi);
#pragma unroll
          for (int d0 = 0; d0 < 2; ++d0) stg[orow * 64 + d0 * 32 + r32] = (bf16)(cvtpk_s(o[d0][r], 0.f) & 0xffffu); }
      asm volatile("s_waitcnt lgkmcnt(0)" ::: "memory");
#pragma unroll
      for (int i = 0; i < 4; ++i) { const int row = i * 8 + (lane >> 3), ch = lane & 7; const u32x4 v = *(SBA_LAS const u32x4*)(stg + row * 64 + ch * 8); *(u32x4*)(Ow + (size_t)row * AD + ch * 8) = v; } }
    asm volatile("s_waitcnt vmcnt(0) lgkmcnt(0)\n\ts_barrier" ::: "memory");
#undef SBA_DMA
#undef SBA_TROW
}
__device__ __forceinline__ void phase(SBA_LAS unsigned char* shm, const bf16* Q, const bf16* K, const bf16* V, bf16* O, int G, int bx) {
    const int vcu = (G % 8 == 0) ? (bx % 8) * (G / 8) + bx / 8 : bx;
    for (int slot = vcu; slot < 256; slot += G) {
        const int bh = slot >> 2, s = slot & 3;
        for (int i = 0; i < 4; ++i) { const int qb = (i == 0) ? 15 - s : (i == 1) ? 8 + s : (i == 2) ? 7 - s : s; unit(bh >> 4, bh & 15, qb, Q, K, V, O, shm); }
    }
}
}

#ifndef MK_N_LAUNCHES
#define MK_N_LAUNCHES 1
#endif
#ifndef ATTN_SIMPLE
#define ATTN_SIMPLE 0
#endif
constexpr int NB = 4, T = 4096, D = 1024, NMETA = 16, NH = 16, HD = 64, FF = 2816, FF2 = 5632;
constexpr int M = NB * T;
constexpr int MROW = M;
constexpr int MR = M + 64;
constexpr float EPS = 1e-6f;
constexpr float C2 = 0.125f * 1.4426950408889634f;
constexpr int NWAVES = 8, NTHREADS = 512, NPHASES = 12;
constexpr size_t WS_WPOOL = 0;
constexpr size_t WS_WUP   = WS_WPOOL + (size_t)4 * 256 * 256 * 2;
constexpr size_t WS_WDOWN = WS_WUP + (size_t)2 * FF2 * D * 2;
constexpr size_t WS_WQKV  = WS_WDOWN + (size_t)2 * D * FF * 2;
constexpr size_t WS_WO    = WS_WQKV + (size_t)3 * D * D * 2;
constexpr size_t WS_HB    = WS_WO + (size_t)D * D * 2;
constexpr size_t WS_U     = WS_HB + (size_t)MR * D * 2;
constexpr size_t WS_HALO  = WS_U + (size_t)MR * FF2 * 2;
constexpr size_t WS_SSQ   = WS_HALO + (size_t)65 * 2 * FF2 * 2;
constexpr size_t WS_HM    = WS_SSQ + (size_t)4 * MR * 4;
constexpr size_t WS_END   = WS_HM + (size_t)16 * D * 4;
constexpr size_t ACT_BYTES = (size_t)MR * D * 2;
static_assert(WS_END <= 268435456, "workspace map exceeds 256 MiB");
static_assert(4 * ACT_BYTES <= (size_t)MR * FF2 * 2, "Q|K|V|O overlay fits in U");
constexpr int LDS_BYTES = 147456;

#define GAS __attribute__((address_space(1)))
#define LAS __attribute__((address_space(3)))
typedef unsigned short bf16;
typedef unsigned v4u __attribute__((ext_vector_type(4)));
typedef unsigned v2u __attribute__((ext_vector_type(2)));
typedef float f32x4 __attribute__((ext_vector_type(4)));
typedef short bf16x8 __attribute__((ext_vector_type(8)));
#define LDS_WAIT() asm volatile("s_waitcnt lgkmcnt(0)" ::: "memory")
__device__ __forceinline__ unsigned pk2(float lo, float hi) { return pg8::cvt_pk_bf16(lo, hi); }
__device__ __forceinline__ float bflo(unsigned w) { return __uint_as_float(w << 16); }
__device__ __forceinline__ float bfhi(unsigned w) { return __uint_as_float(w & 0xffff0000u); }
__device__ __forceinline__ float wave_sum(float v) {
#pragma unroll
    for (int o = 1; o < 64; o <<= 1) v += __shfl_xor(v, o);
    return v;
}
__device__ __forceinline__ float rs_of(float ssq) { return __builtin_amdgcn_rsqf(ssq * (1.0f / (float)D) + EPS); }

__device__ __forceinline__ void p0_transpose_item(const float* W, int K, int N, bf16* WT, int row_off, const float* gain, LAS float* scr, int item, int lane) {
    const int nblk = N / 32, kb = item / nblk, nb = item % nblk, k0 = 64 * kb, n0 = 32 * nb;
#pragma unroll 8
    for (int i = 0; i < 32; ++i) { const int kk = 2 * i + (lane >> 5); float w = W[(size_t)(k0 + kk) * N + n0 + (lane & 31)]; if (gain) w *= gain[k0 + kk]; scr[kk * 33 + (lane & 31)] = w; }
    LDS_WAIT(); asm volatile("" ::: "memory");
    const int c = lane & 7;
#pragma unroll
    for (int j = 0; j < 4; ++j) { const int n = (lane >> 3) + 8 * j; const LAS float* s = scr + (8 * c) * 33 + n;
        v4u o; o.x = pk2(s[0 * 33], s[1 * 33]); o.y = pk2(s[2 * 33], s[3 * 33]); o.z = pk2(s[4 * 33], s[5 * 33]); o.w = pk2(s[6 * 33], s[7 * 33]);
        *(v4u*)(WT + (size_t)(row_off + n0 + n) * K + k0 + 8 * c) = o; }
    LDS_WAIT(); asm volatile("" ::: "memory");
}
template <bool IS_META>
__device__ __forceinline__ void p0_diff_chunk(const float* x, const float* meta, const float* g0, bf16* DIFF, int b, int t0, int lane, LAS float* rsr  ) {
    f32x4 gv[4];
#pragma unroll
    for (int j = 0; j < 4; ++j) gv[j] = *(const f32x4*)(g0 + 4 * lane + 256 * j);
    const f32x4 z4 = {0.f, 0.f, 0.f, 0.f};
    f32x4 S[4];
#pragma unroll
    for (int j = 0; j < 4; ++j) S[j] = z4;
#pragma unroll 2
    for (int k = IS_META ? 16 : 0; k < 32; ++k) {
        const int i = k & 15; const bool outp = k >= 16;
        const int t = IS_META ? (i - 16) : (t0 - 16 + k);
        const float* src = (t >= 0) ? x + ((size_t)b * T + t) * D : meta + (size_t)(16 + t) * D;
        f32x4 v[4]; float s = 0.f;
#pragma unroll
        for (int j = 0; j < 4; ++j) { v[j] = *(const f32x4*)(src + 4 * lane + 256 * j); s += (v[j][0] * v[j][0] + v[j][1] * v[j][1]) + (v[j][2] * v[j][2] + v[j][3] * v[j][3]); }
        const float rs = rs_of(wave_sum(s));
        rsr[i] = rs;
        f32x4 n[4];
#pragma unroll
        for (int j = 0; j < 4; ++j) {
            n[j] = v[j] * rs * gv[j];
            const int w = 2 << j;
            f32x4 old = z4;
            if ((!IS_META && outp) || i >= w) {
                const int to = t - w;
                const float* so = (to >= 0) ? x + ((size_t)b * T + to) * D : meta + (size_t)(16 + to) * D;
                old = *(const f32x4*)(so + 4 * lane + 256 * j) * rsr[(i - w) & 15] * gv[j];
            }
            S[j] += n[j] - old;
        }
        if (outp) {
            const size_t orow = IS_META ? (size_t)(MROW + i) : ((size_t)b * T + t);
#pragma unroll
            for (int j = 0; j < 4; ++j) { const int w = 2 << j; const int cnt = IS_META ? ((i + 1) < w ? (i + 1) : w) : w; const float inv = 1.0f / (float)cnt;
                const f32x4 d = S[j] * inv - n[j]; v2u o; o.x = pk2(d[0], d[1]); o.y = pk2(d[2], d[3]);
                *(v2u*)(DIFF + orow * D + 4 * lane + 256 * j) = o; }
        }
    }
}
template <class F>
__device__ __forceinline__ void thin_item(const bf16* A, int lda, const bf16* Bt, int K, int n0, int lane, F epi) {
    const int m = lane & 15, kq = lane >> 4;
    const bf16* ap = A + (size_t)m * lda + kq * 8; const bf16* bp = Bt + (size_t)(n0 + m) * K + kq * 8;
    f32x4 acc = {0.f, 0.f, 0.f, 0.f};
#pragma unroll 8
    for (int ks = 0; ks < K; ks += 32) { const bf16x8 a = *(const bf16x8*)(ap + ks); const bf16x8 bb = *(const bf16x8*)(bp + ks); acc = __builtin_amdgcn_mfma_f32_16x16x32_bf16(a, bb, acc, 0, 0, 0); }
    epi(4 * kq, n0 + m, acc);
}
__device__ __forceinline__ void thin_res_epi(const float* base, float* hm, bf16* HB, float* ssq, const float* cscale, int row4, int col, const f32x4 acc) {
    const float cs = cscale ? cscale[col] : 1.f; float q[4];
#pragma unroll
    for (int i = 0; i < 4; ++i) { const int r = row4 + i; const float o = base[(size_t)r * D + col] + acc[i] * cs; hm[(size_t)r * D + col] = o; if (HB) HB[(size_t)(MROW + r) * D + col] = (bf16)(pk2(o, 0.f) & 0xffffu); q[i] = o * o; }
#pragma unroll
    for (int i = 0; i < 4; ++i) { float s = q[i]; s += __shfl_xor(s, 1); s += __shfl_xor(s, 2); s += __shfl_xor(s, 4); s += __shfl_xor(s, 8); if ((col & 15) == 0) atomicAdd(ssq + MROW + row4 + i, s); }
}
struct ConvW { float wg[3][8], bg[8], wv[3][8], bv[8]; };
__device__ __forceinline__ void unpack8(const v4u w, float (&f)[8]) { f[0] = bflo(w.x); f[1] = bfhi(w.x); f[2] = bflo(w.y); f[3] = bfhi(w.y); f[4] = bflo(w.z); f[5] = bfhi(w.z); f[6] = bflo(w.w); f[7] = bfhi(w.w); }
__device__ __forceinline__ void convgate_walk(bf16* U, int row0, int nrows, int ch, const float* cw, const float* cb, v4u pg2, v4u pv2, v4u pg1, v4u pv1) {
    float wg[3][8], wv[3][8], bg[8], bv[8];
#pragma unroll
    for (int k = 0; k < 3; ++k)
#pragma unroll
        for (int i = 0; i < 8; ++i) { wg[k][i] = cw[k * FF2 + ch + i]; wv[k][i] = cw[k * FF2 + FF + ch + i]; }
#pragma unroll
    for (int i = 0; i < 8; ++i) { bg[i] = cb[ch + i]; bv[i] = cb[FF + ch + i]; }
    float g2[8], v2[8], g1[8], v1[8];
    unpack8(pg2, g2); unpack8(pv2, v2); unpack8(pg1, g1); unpack8(pv1, v1);
    bf16* p = U + (size_t)row0 * FF2 + ch;
#pragma unroll 4
    for (int r = 0; r < nrows; ++r, p += FF2) {
        const v4u ug = *(const v4u*)p, uv = *(const v4u*)(p + FF);
        float g0[8], v0[8], o[8]; unpack8(ug, g0); unpack8(uv, v0);
#pragma unroll
        for (int i = 0; i < 8; ++i) {
            const float gc = bg[i] + wg[0][i] * g2[i] + wg[1][i] * g1[i] + wg[2][i] * g0[i];
            const float vc = bv[i] + wv[0][i] * v2[i] + wv[1][i] * v1[i] + wv[2][i] * v0[i];
            const float sg = gc * __builtin_amdgcn_rcpf(1.0f + __builtin_amdgcn_exp2f(-1.4426950408889634f * gc));
            o[i] = sg * vc; g2[i] = g1[i]; v2[i] = v1[i]; g1[i] = g0[i]; v1[i] = v0[i];
        }
        v4u w; w.x = pk2(o[0], o[1]); w.y = pk2(o[2], o[3]); w.z = pk2(o[4], o[5]); w.w = pk2(o[6], o[7]);
        *(v4u*)p = w;
    }
}
__device__ __forceinline__ void convgate_phase(bf16* U, const bf16* HALO, const float* cw, const float* cb, int G, int tid) {
    const v4u z = {0u, 0u, 0u, 0u};
    for (int item = blockIdx.x; item < 256; item += G) {
        const int pm = item >> 2, cq = item & 3, rq = tid / 88, cv = tid % 88, ch = 704 * cq + 8 * cv, row0 = 256 * pm + 64 * rq;
        v4u pg2 = z, pv2 = z, pg1 = z, pv1 = z;
        if (tid < 352) {
            const bf16* h2; const bf16* h1;
            if (rq > 0) { h2 = U + (size_t)(row0 - 2) * FF2; h1 = h2 + FF2; }
            else { const int slot = (pm % 16 == 0) ? 64 : pm - 1; h2 = HALO + (size_t)slot * 2 * FF2; h1 = h2 + FF2; }
            pg2 = *(const v4u*)(h2 + ch); pv2 = *(const v4u*)(h2 + FF + ch); pg1 = *(const v4u*)(h1 + ch); pv1 = *(const v4u*)(h1 + FF + ch);
        }
        __syncthreads();
        if (tid < 352) convgate_walk(U, row0, 64, ch, cw, cb, pg2, pv2, pg1, pv1);
        __syncthreads();
    }
    if (blockIdx.x == G - 1 && tid < 352) convgate_walk(U, MROW, 16, 8 * tid, cw, cb, z, z, z, z);
}
__device__ __forceinline__ void attn_simple(const bf16* Q, const bf16* K, const bf16* V, bf16* O, int first, int nblk, int brank, int tid) {
    const int total = NB * NH * T + NH * NMETA;
    for (int base = first + brank * NTHREADS; base < total; base += nblk * NTHREADS) {
        const int idx = base + tid; const bool valid = idx < total;
        int b = 0, h = 0, npos = 0; size_t qrow = 0;
        if (valid) { if (idx < NB * NH * T) { b = idx / (NH * T); h = (idx / T) % NH; const int t = idx % T; qrow = (size_t)b * T + t; npos = NMETA + t; }
                     else { const int mi = idx - NB * NH * T; h = mi / NMETA; const int t = mi % NMETA; qrow = (size_t)MROW + t; npos = t; } }
        float q[64], o[64];
#pragma unroll
        for (int c = 0; c < 8; ++c) { const v4u w = *(const v4u*)(Q + qrow * D + h * HD + 8 * c); float f[8]; unpack8(w, f);
#pragma unroll
            for (int i = 0; i < 8; ++i) { q[8 * c + i] = f[i]; o[8 * c + i] = 0.f; } }
        int pmax = npos;
#pragma unroll
        for (int s = 1; s < 64; s <<= 1) { const int other = __shfl_xor(pmax, s); pmax = other > pmax ? other : pmax; }
        float carry = 1.f;
        for (int p = pmax - 1; p >= 0; --p) {
            const size_t krow = (p >= NMETA) ? ((size_t)b * T + (p - NMETA)) : (size_t)(MROW + p);
            const bf16* kp = K + krow * D + h * HD; const bf16* vp = V + krow * D + h * HD;
            float z = 0.f;
#pragma unroll
            for (int c = 0; c < 8; ++c) { const v4u w = *(const v4u*)(kp + 8 * c); float f[8]; unpack8(w, f);
#pragma unroll
                for (int i = 0; i < 8; ++i) z += q[8 * c + i] * f[i]; }
            z = fminf(fmaxf(z, -80.f), 80.f);
            const float e = __builtin_amdgcn_exp2f(-z), r = __builtin_amdgcn_rcpf(1.0f + e);
            const bool act = p < npos;
            const float a = act ? r * carry : 0.f; carry = act ? carry * (e * r) : carry;
#pragma unroll
            for (int c = 0; c < 8; ++c) { const v4u w = *(const v4u*)(vp + 8 * c); float f[8]; unpack8(w, f);
#pragma unroll
                for (int i = 0; i < 8; ++i) o[8 * c + i] += a * f[i]; }
        }
        if (valid) {
#pragma unroll
            for (int c = 0; c < 8; ++c) { v4u w; w.x = pk2(o[8 * c], o[8 * c + 1]); w.y = pk2(o[8 * c + 2], o[8 * c + 3]); w.z = pk2(o[8 * c + 4], o[8 * c + 5]); w.w = pk2(o[8 * c + 6], o[8 * c + 7]);
                *(v4u*)(O + qrow * D + h * HD + 8 * c) = w; }
        }
    }
}

struct Args { const float* in[15]; float* out; unsigned char* ws; int ph_lo, ph_hi; };
__global__ void __launch_bounds__(NTHREADS, 2) yoco_fwd(Args args) {
    extern __shared__ __attribute__((aligned(16))) unsigned char lds_raw[];
    LAS unsigned char* lds = (LAS unsigned char*)lds_raw;
    cg::grid_group grid = cg::this_grid();
    const int tid = threadIdx.x, lane = tid & 63, wave = __builtin_amdgcn_readfirstlane(tid >> 6);
    const int G = gridDim.x, bx = blockIdx.x;
    const int gw = bx * NWAVES + wave, NGW = G * NWAVES;
    const int tw = (G - 1 - bx) * NWAVES + wave;
    const float* x = args.in[0]; const float* meta = args.in[1]; const float* mix_norm = args.in[2]; const float* ffn_norm = args.in[3];
    const float* pool_w = args.in[4]; const float* pool_scale = args.in[5]; const float* kv_norm = args.in[6]; const float* w_kv = args.in[7];
    const float* w_q = args.in[8]; const float* w_o = args.in[9]; const float* w_up = args.in[10]; const float* conv_w = args.in[11];
    const float* conv_b = args.in[12]; const float* w_down = args.in[13]; const float* final_norm = args.in[14];
    float* out = args.out; unsigned char* ws = args.ws;
    bf16* Wpool_t = (bf16*)(ws + WS_WPOOL); bf16* Wup_t = (bf16*)(ws + WS_WUP); bf16* Wdown_t = (bf16*)(ws + WS_WDOWN); bf16* Wqkv_t = (bf16*)(ws + WS_WQKV); bf16* Wo_t = (bf16*)(ws + WS_WO);
    bf16* HB = (bf16*)(ws + WS_HB); bf16* U = (bf16*)(ws + WS_U); bf16* HALO = (bf16*)(ws + WS_HALO);
    bf16* DIFF = U; bf16* QB = U; bf16* KB = (bf16*)(ws + WS_U + ACT_BYTES); bf16* VB = (bf16*)(ws + WS_U + 2 * ACT_BYTES); bf16* OB = (bf16*)(ws + WS_U + 3 * ACT_BYTES);
    float* SSQ = (float*)(ws + WS_SSQ); float* HM = (float*)(ws + WS_HM);
    float* ssq1 = SSQ, *ssq2 = SSQ + MR, *ssq3 = SSQ + 2 * MR, *ssq4 = SSQ + 3 * MR;
    const int lo = args.ph_lo, hi = args.ph_hi;
#define IN(k) (lo <= (k) && (k) < hi)
#define SEAM(k) do { if (IN(k) && IN((k) + 1)) grid.sync(); } while (0)

    if (IN(0)) {
        LAS float* scr = (LAS float*)(lds + wave * 16384);
        constexpr int I_POOL = 4 * 32, I_UP = (D / 64) * (FF2 / 32), I_DOWN = (FF / 64) * (D / 32), I_Q = (D / 64) * (D / 32), I_KV = (D / 64) * (2 * D / 32), I_O = I_Q;
        constexpr int NITEMS = I_POOL + 2 * I_UP + 2 * I_DOWN + I_Q + I_KV + I_O;
        for (int it = gw; it < NITEMS; it += NGW) {
            int r = it;
            if (r < I_POOL) { const int g = r / 32; p0_transpose_item(pool_w + (size_t)g * 65536, 256, 256, Wpool_t, 256 * g, nullptr, scr, r % 32, lane); continue; } r -= I_POOL;
            if (r < 2 * I_UP) { const int l = r / I_UP; p0_transpose_item(w_up + (size_t)l * D * FF2, D, FF2, Wup_t + (size_t)l * FF2 * D, 0, ffn_norm + l * D, scr, r % I_UP, lane); continue; } r -= 2 * I_UP;
            if (r < 2 * I_DOWN) { const int l = r / I_DOWN; p0_transpose_item(w_down + (size_t)l * FF * D, FF, D, Wdown_t + (size_t)l * D * FF, 0, nullptr, scr, r % I_DOWN, lane); continue; } r -= 2 * I_DOWN;
            if (r < I_Q) { p0_transpose_item(w_q, D, D, Wqkv_t, 0, mix_norm + D, scr, r, lane); continue; } r -= I_Q;
            if (r < I_KV) { p0_transpose_item(w_kv, D, 2 * D, Wqkv_t, D, kv_norm, scr, r, lane); continue; } r -= I_KV;
            p0_transpose_item(w_o, D, D, Wo_t, 0, nullptr, scr, r, lane);
        }
        for (int c = NGW - 1 - gw; c < M / 16 + 1; c += NGW) {
            if (c < M / 16) p0_diff_chunk<false>(x, meta, mix_norm, DIFF, c / (T / 16), (c % (T / 16)) * 16, lane, scr);
            else p0_diff_chunk<true>(x, meta, mix_norm, DIFF, 0, 0, lane, scr);
        }
        for (int i = bx * NTHREADS + tid; i < 4 * MR; i += G * NTHREADS) SSQ[i] = 0.f;
    }
    SEAM(0);
    if (IN(1)) {
        pg8::Gemm g{DIFF, Wpool_t, M, D, 256, D, 256}; pg8::StaticOrder S; S.init(M, D, G, bx);
        pg8::EpiRes E{x, out, HB, ssq1, pool_scale, D};
        pg8::gemm_phase<pg8::EpiRes, pg8::StaticOrder, false, true>(lds, g, S, E);
        for (int it = tw; it < D / 16; it += NGW) { const int n0 = it * 16, gsel = n0 / 256;
            thin_item(DIFF + (size_t)MROW * D + 256 * gsel, D, Wpool_t, 256, n0, lane, [&](int row4, int col, const f32x4 acc) { thin_res_epi(meta, HM, HB, ssq1, pool_scale, row4, col, acc); }); }
    }
    SEAM(1);
#define FFN_PHASES(l, pb, ssq_in, ssq_out) do { \
          \
        if (IN(pb)) { \
            const bf16* Wt = Wup_t + (size_t)(l) * FF2 * D; \
            pg8::Gemm g{HB, Wt, M, FF2, D, D, 0}; pg8::StaticOrder S; S.init(M, FF2, G, bx); \
            pg8::EpiRsBf16 E{U, FF2, ssq_in, 0, 0, 1.f, HALO}; \
            pg8::gemm_phase<pg8::EpiRsBf16, pg8::StaticOrder, true, true>(lds, g, S, E); \
            for (int it = tw; it < FF2 / 16; it += NGW) \
                thin_item(HB + (size_t)MROW * D, D, Wt, D, it * 16, lane, [&](int row4, int col, const f32x4 acc) { \
                    _Pragma("unroll") \
                    for (int i = 0; i < 4; ++i) { const int r = row4 + i; const bf16 v = (bf16)(pk2(acc[i] * rs_of(ssq_in[MROW + r]), 0.f) & 0xffffu); \
                        U[(size_t)(MROW + r) * FF2 + col] = v; if (r >= 14) HALO[(size_t)(64 * 2 + (r - 14)) * FF2 + col] = v; } }); \
        } \
        SEAM(pb); \
          \
        if (IN(pb + 1)) convgate_phase(U, HALO, conv_w + (size_t)(l) * 3 * FF2, conv_b + (size_t)(l) * FF2, G, tid); \
        SEAM(pb + 1); \
          \
        if (IN(pb + 2)) { \
            const bf16* Wt = Wdown_t + (size_t)(l) * D * FF; \
            pg8::Gemm g{U, Wt, M, D, FF, FF2, 0}; pg8::StaticOrder S; S.init(M, D, G, bx); \
            pg8::EpiRes E{out, out, ((l) == 0) ? HB : nullptr, ssq_out, nullptr, D}; \
            pg8::gemm_phase<pg8::EpiRes, pg8::StaticOrder, false, true>(lds, g, S, E); \
            if ((l) == 0) \
                for (int it = tw; it < D / 16; it += NGW) \
                    thin_item(U + (size_t)MROW * FF2, FF2, Wt, FF, it * 16, lane, [&](int row4, int col, const f32x4 acc) { thin_res_epi(HM, HM, HB, ssq_out, nullptr, row4, col, acc); }); \
        } \
        SEAM(pb + 2); } while (0)
    FFN_PHASES(0, 2, ssq1, ssq2);
    if (IN(5)) {
        pg8::Gemm g{HB, Wqkv_t, M, 3 * D, D, D, 0}; pg8::StaticOrder S; S.init(M, 3 * D, G, bx);
        pg8::EpiRsBf16 E{QB, D, ssq2, D, ACT_BYTES / 2, C2, nullptr};
        pg8::gemm_phase<pg8::EpiRsBf16, pg8::StaticOrder, true, true>(lds, g, S, E);
        for (int it = tw; it < 3 * D / 16; it += NGW)
            thin_item(HB + (size_t)MROW * D, D, Wqkv_t, D, it * 16, lane, [&](int row4, int col, const f32x4 acc) {
                const int tsel = col / D, cc = col % D; bf16* dst = QB + (size_t)tsel * (ACT_BYTES / 2);
#pragma unroll
                for (int i = 0; i < 4; ++i) { const int r = row4 + i; const float v = acc[i] * rs_of(ssq2[MROW + r]) * (tsel == 0 ? C2 : 1.f); dst[(size_t)(MROW + r) * D + cc] = (bf16)(pk2(v, 0.f) & 0xffffu); } });
        for (int i = bx * NTHREADS + tid; i < 2 * 48 * D / 8; i += G * NTHREADS) { const int which = i / (48 * D / 8), off = i % (48 * D / 8);
            *(v4u*)((which ? VB : KB) + (size_t)(MROW + 16) * D + (size_t)off * 8) = (v4u){0u, 0u, 0u, 0u}; }
    }
    SEAM(5);
    if (IN(6)) {
#if ATTN_SIMPLE
        attn_simple(QB, KB, VB, OB, 0, G, bx, tid);
#else
        sba::phase(lds, QB, KB, VB, OB, G, bx);
        if (bx == G - 1) attn_simple(QB, KB, VB, OB, NB * NH * T, 1, 0, tid);
#endif
    }
    SEAM(6);
    if (IN(7)) {
        pg8::Gemm g{OB, Wo_t, M, D, D, D, 0}; pg8::StaticOrder S; S.init(M, D, G, bx);
        pg8::EpiRes E{out, out, HB, ssq3, nullptr, D};
        pg8::gemm_phase<pg8::EpiRes, pg8::StaticOrder, false, true>(lds, g, S, E);
        for (int it = tw; it < D / 16; it += NGW)
            thin_item(OB + (size_t)MROW * D, D, Wo_t, D, it * 16, lane, [&](int row4, int col, const f32x4 acc) { thin_res_epi(HM, HM, HB, ssq3, nullptr, row4, col, acc); });
    }
    SEAM(7);
    FFN_PHASES(1, 8, ssq3, ssq4);
#undef FFN_PHASES
    if (IN(11)) {
        f32x4 gv[4];
#pragma unroll
        for (int j = 0; j < 4; ++j) gv[j] = *(const f32x4*)(final_norm + 4 * lane + 256 * j);
        for (int r = gw; r < M; r += NGW) { const float rs = rs_of(ssq4[r]); float* p = out + (size_t)r * D + 4 * lane;
#pragma unroll
            for (int j = 0; j < 4; ++j) { const f32x4 v = *(const f32x4*)(p + 256 * j); *(f32x4*)(p + 256 * j) = v * rs * gv[j]; } }
    }
#undef IN
#undef SEAM
}

extern "C" void kernel_launch(void* const* d_in, const int* in_sizes, int n_in, void* d_out, int out_size, void* d_ws, size_t ws_size, hipStream_t stream) {
    static int grid = 0;
    if (grid == 0) {
        if (n_in != 15 || in_sizes[0] != M * D || out_size != M * D || ws_size < WS_END) { fprintf(stderr, "kernel_launch: unexpected shapes (n_in %d, in0 %d, out %d, ws %zu, need %zu); nothing launched\n", n_in, n_in > 0 ? in_sizes[0] : -1, out_size, ws_size, (size_t)WS_END); grid = -1; return; }
        int dev = 0, cus = 0, per_cu = 0;
        if (hipGetDevice(&dev) != hipSuccess || hipDeviceGetAttribute(&cus, hipDeviceAttributeMultiprocessorCount, dev) != hipSuccess) { grid = -1; return; }
        if (hipFuncSetAttribute((const void*)yoco_fwd, hipFuncAttributeMaxDynamicSharedMemorySize, LDS_BYTES) != hipSuccess) { fprintf(stderr, "kernel_launch: hipFuncSetAttribute failed\n"); grid = -1; return; }
        if (hipOccupancyMaxActiveBlocksPerMultiprocessor(&per_cu, (const void*)yoco_fwd, NTHREADS, LDS_BYTES) != hipSuccess || per_cu < 1) per_cu = 1;
        (void)hipGetLastError();
        grid = cus * per_cu;
    }
    if (grid < 0) return;
    Args a{};
    for (int i = 0; i < 15; ++i) a.in[i] = (const float*)d_in[i];
    a.out = (float*)d_out; a.ws = (unsigned char*)d_ws;
#if MK_N_LAUNCHES == 1
    a.ph_lo = 0; a.ph_hi = NPHASES;
    void* kargs[] = {&a};
    hipError_t e = hipLaunchCooperativeKernel((const void*)yoco_fwd, dim3(grid), dim3(NTHREADS), kargs, LDS_BYTES, stream);
    if (e != hipSuccess) fprintf(stderr, "kernel_launch: cooperative launch failed: %s (grid %d)\n", hipGetErrorString(e), grid);
#else
    for (int p = 0; p < NPHASES; ++p) { a.ph_lo = p; a.ph_hi = p + 1; hipLaunchKernelGGL(yoco_fwd, dim3(grid), dim3(NTHREADS), LDS_BYTES, stream, a); }
#endif
}
```

```cpp
#include <hip/hip_runtime.h>
#include <hip/hip_cooperative_groups.h>
#include <cstdio>
#include <cstdint>
namespace cg = cooperative_groups;
namespace pg8 {
#define PG8_LAS __attribute__((address_space(3)))
typedef unsigned short bf16_t;
typedef short bf16x8 __attribute__((ext_vector_type(8)));
typedef float f32x4 __attribute__((ext_vector_type(4)));
typedef unsigned u32x4 __attribute__((ext_vector_type(4)));
constexpr int BM = 256, BK = 64, HALF = 128, HTB = HALF * BK * 2  , STAGE_BYTES = 8 * HTB, NXCD = 8, WGM = 8;

__host__ __device__ __forceinline__ int lds_byte(int r, int c) { const int st = (r >> 4) * 2 + (c >> 5), rr = r & 15, cc = c & 31, ob = rr * 64 + cc * 2; return st * 1024 + (ob ^ (((ob >> 9) & 1) << 5)); }
__host__ __device__ __forceinline__ void stage_rc(int b, int& R, int& C) { const int st = b / 1024, sb = b % 1024, swz = sb ^ (((sb >> 9) & 1) << 5); R = (st >> 1) * 16 + swz / 64; C = (st & 1) * 32 + (swz % 64) / 2; }
__host__ __device__ __forceinline__ int perm32(int rho) { const int n = rho >> 4, i = rho & 15; return 8 * (i >> 2) + 4 * n + (i & 3); }

struct Unit { int pm, pn; };
struct Gemm { const bf16_t* A; const bf16_t* Bt; int M, N, K, lda, acs, amode; };
__host__ __device__ __forceinline__ int hbrow(int r) { return r + 16 * ((r >> 12) + 1); }

struct StaticOrder {
    int nM, nN, nwg, G, c;
    __host__ __device__ void init(int M, int N, int G_, int c_) { nM = M / BM; nN = N / BM; nwg = nM * nN; G = G_; c = c_; }
    __host__ __device__ bool next(int i, Unit& u) const {
        const long L = (long)i * G + c; if (L >= nwg) return false;
        int wgid = (int)L; { const int q = nwg / NXCD, r = nwg % NXCD, xcd = wgid % NXCD, off = wgid / NXCD; wgid = (xcd < r ? xcd * (q + 1) : r * (q + 1) + (xcd - r) * q) + off; }
        const int nig = WGM * nN, gid = wgid / nig, fm = gid * WGM, gsz = (nM - fm) < WGM ? (nM - fm) : WGM;
        u.pm = fm + ((wgid % nig) % gsz); u.pn = (wgid % nig) / gsz; return true;
    }
    __device__ __forceinline__ void a_ready(const Unit&) const {}
    __device__ __forceinline__ void done(const Unit&) const {}
};

__device__ __forceinline__ unsigned cvt_pk_bf16(float lo, float hi) { unsigned r; asm volatile("v_cvt_pk_bf16_f32 %0, %1, %2" : "=v"(r) : "v"(lo), "v"(hi)); return r; }
typedef unsigned u32x2 __attribute__((ext_vector_type(2)));
constexpr float RMS_EPS_C = 1e-6f;
struct EpiRsBf16 {
    static constexpr bool PERM = true, AFTER_DRAIN = false;
    bf16_t* O; int ldc; const float* ssq; int split_cols; size_t split_stride; float scale0; bf16_t* halo;
    __device__ __forceinline__ void operator()(const f32x4 (&acc)[2][2][4][2], const Unit& u, int wr, int wc, int fr, int fq) const {
        const int row0 = u.pm * BM + wr * 64 + fr; int colt = u.pn * BM; bf16_t* base = O;
        float sc = 1.f; if (split_cols) { const int t = colt / split_cols; base += (size_t)t * split_stride; colt -= t * split_cols; if (t == 0) sc = scale0; }
        const int col0 = colt + wc * 32 + 8 * fq;
#pragma unroll
        for (int ai = 0; ai < 2; ++ai)
#pragma unroll
            for (int m = 0; m < 4; ++m) { const int row = row0 + ai * HALF + m * 16; const float rs = __builtin_amdgcn_rsqf(ssq[row] * (1.0f / 1024.0f) + RMS_EPS_C) * sc;
                bf16_t* rowp = base + (size_t)row * ldc + col0;
#pragma unroll
                for (int bj = 0; bj < 2; ++bj) { const f32x4 v0 = acc[ai][bj][m][0] * rs, v1 = acc[ai][bj][m][1] * rs;
                    u32x4 w; w.x = cvt_pk_bf16(v0[0], v0[1]); w.y = cvt_pk_bf16(v0[2], v0[3]); w.z = cvt_pk_bf16(v1[0], v1[1]); w.w = cvt_pk_bf16(v1[2], v1[3]);
                    *(u32x4*)(rowp + bj * HALF) = w;
                    if (halo != nullptr && ai == 1 && m == 3 && wr == 1 && fr >= 14) *(u32x4*)(halo + (size_t)(u.pm * 2 + (fr - 14)) * ldc + col0 + bj * HALF) = w; } }
    }
};
struct EpiRes {
    static constexpr bool PERM = true, AFTER_DRAIN = false;
    const float* base; const bf16_t* baseb; float* out; bf16_t* hb; float* ssq; const float* cscale; int ldc;
    __device__ __forceinline__ void operator()(const f32x4 (&acc)[2][2][4][2], const Unit& u, int wr, int wc, int fr, int fq) const {
        const int col0 = u.pn * BM + wc * 32 + 8 * fq;
        f32x4 cs[2][2];
#pragma unroll
        for (int bj = 0; bj < 2; ++bj)
#pragma unroll
            for (int n = 0; n < 2; ++n) cs[bj][n] = cscale ? *(const f32x4*)(cscale + col0 + bj * HALF + n * 4) : (f32x4){1.f, 1.f, 1.f, 1.f};
#pragma unroll
        for (int ai = 0; ai < 2; ++ai) {
            u32x4 wb[4][2]; f32x4 fb[4][2][2];
#pragma unroll
            for (int m = 0; m < 4; ++m) { const int r_ = u.pm * BM + ai * HALF + wr * 64 + m * 16 + fr; const size_t off = (size_t)r_ * ldc + col0, offh = (size_t)hbrow(r_) * ldc + col0;
#pragma unroll
                for (int bj = 0; bj < 2; ++bj) { if (baseb != nullptr) wb[m][bj] = *(const u32x4*)(baseb + offh + bj * HALF);
                    else { fb[m][bj][0] = __builtin_nontemporal_load((const f32x4*)(base + off + bj * HALF)); fb[m][bj][1] = __builtin_nontemporal_load((const f32x4*)(base + off + bj * HALF + 4)); } } }
#pragma unroll
            for (int m = 0; m < 4; ++m) { const int r = u.pm * BM + ai * HALF + wr * 64 + m * 16 + fr; const size_t off = (size_t)r * ldc + col0, offh = (size_t)hbrow(r) * ldc + col0; float q = 0.f;
#pragma unroll
                for (int bj = 0; bj < 2; ++bj) { f32x4 b0, b1;
                    if (baseb != nullptr) { const u32x4 w = wb[m][bj];
                        b0 = (f32x4){__uint_as_float(w.x << 16), __uint_as_float(w.x & 0xffff0000u), __uint_as_float(w.y << 16), __uint_as_float(w.y & 0xffff0000u)};
                        b1 = (f32x4){__uint_as_float(w.z << 16), __uint_as_float(w.z & 0xffff0000u), __uint_as_float(w.w << 16), __uint_as_float(w.w & 0xffff0000u)}; }
                    else { b0 = fb[m][bj][0]; b1 = fb[m][bj][1]; }
                    const f32x4 o0 = b0 + acc[ai][bj][m][0] * cs[bj][0], o1 = b1 + acc[ai][bj][m][1] * cs[bj][1];
                    if (out != nullptr) { *(f32x4*)(out + off + bj * HALF) = o0; *(f32x4*)(out + off + bj * HALF + 4) = o1; }
                    q += ((o0[0] * o0[0] + o0[1] * o0[1]) + (o0[2] * o0[2] + o0[3] * o0[3])) + ((o1[0] * o1[0] + o1[1] * o1[1]) + (o1[2] * o1[2] + o1[3] * o1[3]));
                    if (hb != nullptr) { u32x4 w; w.x = cvt_pk_bf16(o0[0], o0[1]); w.y = cvt_pk_bf16(o0[2], o0[3]); w.z = cvt_pk_bf16(o1[0], o1[1]); w.w = cvt_pk_bf16(o1[2], o1[3]); *(u32x4*)(hb + offh + bj * HALF) = w; } }
                q += __shfl_xor(q, 16); q += __shfl_xor(q, 32);
                if (fq == 0) atomicAdd(ssq + r, q); }
            asm volatile("" ::: "memory");
        }
    }
};

struct EpiConvGate {
    static constexpr bool PERM = true, AFTER_DRAIN = false;
    bf16_t* G; const float* ssq; const float* cw; const float* cb;
    template <int N, bool HASPREV> static __device__ __forceinline__ float rowm(float cur, float prev) {
        const int top = HASPREV ? __builtin_amdgcn_update_dpp(0, __builtin_bit_cast(int, prev), N == 1 ? 0x10f : 0x10e, 0xf, 0xf, true) : 0;
        return __builtin_bit_cast(float, __builtin_amdgcn_update_dpp(top, __builtin_bit_cast(int, cur), N == 1 ? 0x111 : 0x112, 0xf, 0xf, false));
    }
    __device__ __forceinline__ void operator()(const f32x4 (&acc)[2][2][4][2], const Unit& u, int wr, int wc, int fr, int fq) const {
        const int batch = u.pm / 17, ti = u.pm % 17, j0 = 128 * u.pn + 32 * wc + 8 * fq;
        float rs[2][4]; unsigned pk[2][4][4];
#pragma unroll
        for (int ai = 0; ai < 2; ++ai)
#pragma unroll
            for (int m = 0; m < 4; ++m) { const int t = 248 * ti - 2 + 62 * (2 * ai + wr) + fr + 16 * m; const int si = (t >= 0) ? batch * 4096 + t : 16384 + 16 + t; rs[ai][m] = __builtin_amdgcn_rsqf(ssq[si] * (1.0f / 1024.0f) + RMS_EPS_C); }
#pragma unroll
        for (int n = 0; n < 2; ++n)
#pragma unroll
            for (int ep = 0; ep < 2; ++ep) {
                float o[2][2][4];
#pragma unroll
                for (int c = 0; c < 2; ++c) { const int e = 2 * ep + c, ch = j0 + 4 * n + e;
                    const float wg0 = cw[ch], wg1 = cw[5632 + ch], wg2 = cw[2 * 5632 + ch], bg = cb[ch];
                    const float wv0 = cw[2816 + ch], wv1 = cw[5632 + 2816 + ch], wv2 = cw[2 * 5632 + 2816 + ch], bv = cb[2816 + ch];
#pragma unroll
                    for (int ai = 0; ai < 2; ++ai) {
                        float ug[4], uv[4];
#pragma unroll
                        for (int m = 0; m < 4; ++m) { ug[m] = acc[ai][0][m][n][e] * rs[ai][m]; uv[m] = acc[ai][1][m][n][e] * rs[ai][m]; }
#pragma unroll
                        for (int m = 0; m < 4; ++m) {
                            const float p1g = (m > 0) ? rowm<1, true>(ug[m], ug[m > 0 ? m - 1 : 0]) : rowm<1, false>(ug[m], 0.f), p2g = (m > 0) ? rowm<2, true>(ug[m], ug[m > 0 ? m - 1 : 0]) : rowm<2, false>(ug[m], 0.f);
                            const float p1v = (m > 0) ? rowm<1, true>(uv[m], uv[m > 0 ? m - 1 : 0]) : rowm<1, false>(uv[m], 0.f), p2v = (m > 0) ? rowm<2, true>(uv[m], uv[m > 0 ? m - 1 : 0]) : rowm<2, false>(uv[m], 0.f);
                            const float gc = __builtin_fmaf(wg0, p2g, __builtin_fmaf(wg1, p1g, __builtin_fmaf(wg2, ug[m], bg)));
                            const float vc = __builtin_fmaf(wv0, p2v, __builtin_fmaf(wv1, p1v, __builtin_fmaf(wv2, uv[m], bv)));
                            o[ai][c][m] = gc * __builtin_amdgcn_rcpf(1.0f + __builtin_amdgcn_exp2f(-1.4426950408889634f * gc)) * vc;
                        }
                    }
                }
#pragma unroll
                for (int ai = 0; ai < 2; ++ai)
#pragma unroll
                    for (int m = 0; m < 4; ++m) pk[ai][m][2 * n + ep] = cvt_pk_bf16(o[ai][0][m], o[ai][1][m]);
            }
#pragma unroll
        for (int ai = 0; ai < 2; ++ai)
#pragma unroll
            for (int m = 0; m < 4; ++m) { const int l = 16 * m + fr, t = 248 * ti - 2 + 62 * (2 * ai + wr) + l;
                if (l >= 2 && t < 4096) { u32x4 w; w.x = pk[ai][m][0]; w.y = pk[ai][m][1]; w.z = pk[ai][m][2]; w.w = pk[ai][m][3]; *(u32x4*)(G + (size_t)(batch * 4096 + t) * 2816 + j0) = w; } }
    }
};

template <class Epi, class Sched, bool ALIGN_EPI = false, bool SP2 = false>
__device__ __forceinline__ void gemm_phase(PG8_LAS unsigned char* lds, const Gemm g, const Sched& S, const Epi& E) {
    const int tid = threadIdx.x, wid = __builtin_amdgcn_readfirstlane(tid >> 6), lane = tid & 63, wr = wid >> 2, wc = wid & 3, fr = lane & 15, fq = lane >> 4;
    const int K = g.K, nt = K / BK;
    unsigned voffA[2], voffB[2];
#pragma unroll
    for (int i = 0; i < 2; ++i) { int R, C; stage_rc(tid * 16 + i * 8192, R, C); const int Rb = Epi::PERM ? ((R & ~31) + perm32(R & 31)) : R;
        voffA[i] = (unsigned)((g.amode == 2 ? R - 2 * (R >> 6) : R) * g.lda + C) * 2u; voffB[i] = (unsigned)(Rb * K + C) * 2u; }
    const size_t kstep = (size_t)(BK * 2);
    const size_t hstepA = (size_t)(g.amode == 2 ? 124 : HALF) * g.lda * 2, hstepB = (size_t)HALF * K * 2;
    const size_t tstepB = 2 * hstepB; const size_t acsb = (size_t)g.acs * 2; const size_t rowb = (size_t)g.lda * 2;
#define PG8_AROW(pm) ((size_t)(g.amode == 0 ? (pm) * 256 : g.amode == 1 ? (pm) * 256 + 16 * (((pm) >> 4) + 1) : ((pm) / 17) * 4112 + 14 + 248 * ((pm) % 17)))
    const unsigned ldsw = (unsigned)wid * 1024u;
    const int aoff = lds_byte(wr * 64 + fr, fq * 8), boff = lds_byte(wc * 32 + fr, fq * 8);
#define PG8_SA(b, h) (((b) * 2 + (h)) * HTB)
#define PG8_SB(b, h) ((4 + (b) * 2 + (h)) * HTB)
#define PG8_STAGE(bufoff, gbase, voff) do { _Pragma("unroll") for (int _i = 0; _i < 2; ++_i) \
        __builtin_amdgcn_global_load_lds((const unsigned*)((const char*)(gbase) + (voff)[_i]), (PG8_LAS unsigned*)(lds + (bufoff) + ldsw + _i * 8192), 16, 0, 0); } while (0)
#define PG8_LDA(dst, b, h) do { _Pragma("unroll") for (int m = 0; m < 4; ++m) _Pragma("unroll") for (int k = 0; k < 2; ++k) dst[m][k] = *(const PG8_LAS bf16x8*)(lds + PG8_SA(b, h) + aoff + m * 2048 + k * 1024); } while (0)
#define PG8_LDB(dst, b, h) do { _Pragma("unroll") for (int n = 0; n < 2; ++n) _Pragma("unroll") for (int k = 0; k < 2; ++k) dst[n][k] = *(const PG8_LAS bf16x8*)(lds + PG8_SB(b, h) + boff + n * 2048 + k * 1024); } while (0)
#define PG8_MMA(ai, bj, At, Bt) do { __builtin_amdgcn_s_setprio(1); _Pragma("unroll") for (int m = 0; m < 4; ++m) _Pragma("unroll") for (int n = 0; n < 2; ++n) _Pragma("unroll") for (int k = 0; k < 2; ++k) \
        acc[ai][bj][m][n] = __builtin_amdgcn_mfma_f32_16x16x32_bf16(Bt[n][k], At[m][k], acc[ai][bj][m][n], 0, 0, 0); __builtin_amdgcn_s_setprio(0); } while (0)
#define PG8_WAIT_V(n) asm volatile("s_waitcnt vmcnt(" #n ")" ::: "memory")
#define PG8_WAIT_L(n) asm volatile("s_waitcnt lgkmcnt(" #n ")" ::: "memory")
#define PG8_BAR __builtin_amdgcn_s_barrier()
#define PG8_SCHED __builtin_amdgcn_sched_barrier(0)
    Unit cur, nxt; int ui = 0;
    if (!S.next(0, cur)) return;
    f32x4 acc[2][2][4][2];
#pragma unroll
    for (int a = 0; a < 2; ++a)
#pragma unroll
        for (int b = 0; b < 2; ++b)
#pragma unroll
            for (int m = 0; m < 4; ++m)
#pragma unroll
                for (int n = 0; n < 2; ++n) acc[a][b][m][n] = (f32x4){0.f, 0.f, 0.f, 0.f};
    bf16x8 At[4][2], B0[2][2], B1[2][2];
    const char* cA = (const char*)g.A + PG8_AROW(cur.pm) * rowb + (size_t)cur.pn * acsb; const char* cB = (const char*)g.Bt + (size_t)cur.pn * tstepB;
    S.a_ready(cur);
    if constexpr (SP2) {
        PG8_STAGE(PG8_SB(0, 0), cB, voffB); PG8_STAGE(PG8_SB(0, 1), cB + hstepB, voffB); PG8_STAGE(PG8_SA(0, 0), cA, voffA); PG8_STAGE(PG8_SA(0, 1), cA + hstepA, voffA);
        if (wr == 1) PG8_BAR;
        PG8_WAIT_V(2); PG8_BAR;
        PG8_STAGE(PG8_SB(1, 0), cB + kstep, voffB); PG8_STAGE(PG8_SA(1, 0), cA + kstep, voffA); PG8_STAGE(PG8_SB(1, 1), cB + hstepB + kstep, voffB);
        PG8_WAIT_V(6); PG8_BAR;
    } else {
        PG8_STAGE(PG8_SB(0, 0), cB, voffB); PG8_STAGE(PG8_SA(0, 0), cA, voffA); PG8_STAGE(PG8_SB(0, 1), cB + hstepB, voffB); PG8_STAGE(PG8_SA(0, 1), cA + hstepA, voffA);
        if (wr == 1) PG8_BAR;
        PG8_WAIT_V(4); PG8_BAR;
        PG8_STAGE(PG8_SB(1, 0), cB + kstep, voffB); PG8_STAGE(PG8_SA(1, 0), cA + kstep, voffA); PG8_STAGE(PG8_SB(1, 1), cB + hstepB + kstep, voffB);
        PG8_WAIT_V(6); PG8_BAR;
    }
    for (;;) {
        const bool has_next = S.next(ui + 1, nxt);
        const char* nA = has_next ? (const char*)g.A + PG8_AROW(nxt.pm) * rowb + (size_t)nxt.pn * acsb : cA; const char* nB = has_next ? (const char*)g.Bt + (size_t)nxt.pn * tstepB : cB;
        for (int t = 0; t < nt; t += 2) {
            const bool last = (t == nt - 2);
            const char* a1 = cA + (size_t)(t + 1) * kstep;
            const char* a2 = last ? nA : cA + (size_t)(t + 2) * kstep; const char* b2 = last ? nB : cB + (size_t)(t + 2) * kstep;
            const char* a3 = a2 + kstep; const char* b3 = b2 + kstep;
            if (last && has_next) S.a_ready(nxt);
            if constexpr (SP2) {
            PG8_LDB(B0, 0, 0); PG8_LDB(B1, 0, 1); PG8_SCHED; PG8_LDA(At, 0, 0); PG8_STAGE(PG8_SA(1, 1), a1 + hstepA, voffA);
            PG8_WAIT_V(8); PG8_WAIT_L(0); PG8_BAR; PG8_MMA(0, 0, At, B0); PG8_MMA(0, 1, At, B1); PG8_BAR; PG8_SCHED;
            PG8_LDA(At, 0, 1); PG8_STAGE(PG8_SB(0, 0), b2, voffB); PG8_STAGE(PG8_SB(0, 1), b2 + hstepB, voffB); PG8_STAGE(PG8_SA(0, 0), a2, voffA);
            PG8_WAIT_V(8); PG8_WAIT_L(0); PG8_BAR; PG8_MMA(1, 0, At, B0); PG8_MMA(1, 1, At, B1); PG8_BAR; PG8_SCHED;
            PG8_LDB(B0, 1, 0); PG8_LDB(B1, 1, 1); PG8_SCHED; PG8_LDA(At, 1, 0); PG8_STAGE(PG8_SA(0, 1), a2 + hstepA, voffA);
            PG8_WAIT_V(8); PG8_WAIT_L(0); PG8_BAR; PG8_MMA(0, 0, At, B0); PG8_MMA(0, 1, At, B1); PG8_BAR; PG8_SCHED;
            PG8_LDA(At, 1, 1); PG8_STAGE(PG8_SB(1, 0), b3, voffB); PG8_STAGE(PG8_SB(1, 1), b3 + hstepB, voffB); PG8_STAGE(PG8_SA(1, 0), a3, voffA);
            PG8_WAIT_V(8); PG8_WAIT_L(0); PG8_BAR; PG8_MMA(1, 0, At, B0); PG8_MMA(1, 1, At, B1); PG8_BAR; PG8_SCHED;
            } else {
            PG8_LDB(B0, 0, 0); PG8_SCHED; PG8_LDA(At, 0, 0); PG8_STAGE(PG8_SA(1, 1), a1 + hstepA, voffA);
            PG8_WAIT_L(8); PG8_BAR; PG8_WAIT_L(0); PG8_MMA(0, 0, At, B0); PG8_BAR; PG8_SCHED;
            PG8_LDB(B1, 0, 1); PG8_STAGE(PG8_SB(0, 0), b2, voffB);
            PG8_BAR; PG8_WAIT_L(0); PG8_MMA(0, 1, At, B1); PG8_BAR;
            PG8_LDA(At, 0, 1); PG8_STAGE(PG8_SA(0, 0), a2, voffA);
            PG8_BAR; PG8_WAIT_L(0); PG8_MMA(1, 0, At, B0); PG8_BAR; PG8_SCHED;
            PG8_STAGE(PG8_SB(0, 1), b2 + hstepB, voffB);
            PG8_WAIT_V(6); PG8_BAR; PG8_MMA(1, 1, At, B1); PG8_BAR;
            PG8_LDB(B0, 1, 0); PG8_SCHED; PG8_LDA(At, 1, 0); PG8_STAGE(PG8_SA(0, 1), a2 + hstepA, voffA);
            PG8_WAIT_L(8); PG8_BAR; PG8_WAIT_L(0); PG8_MMA(0, 0, At, B0); PG8_BAR; PG8_SCHED;
            PG8_LDB(B1, 1, 1); PG8_STAGE(PG8_SB(1, 0), b3, voffB);
            PG8_BAR; PG8_WAIT_L(0); PG8_MMA(0, 1, At, B1); PG8_BAR;
            PG8_LDA(At, 1, 1); PG8_STAGE(PG8_SA(1, 0), a3, voffA);
            PG8_BAR; PG8_WAIT_L(0); PG8_MMA(1, 0, At, B0); PG8_BAR; PG8_SCHED;
            PG8_STAGE(PG8_SB(1, 1), b3 + hstepB, voffB);
            PG8_WAIT_V(6); PG8_BAR; PG8_MMA(1, 1, At, B1); PG8_BAR;
            }
        }
        if constexpr (ALIGN_EPI) { if (wr == 0) PG8_BAR; }
        if constexpr (!Epi::AFTER_DRAIN) { E(acc, cur, wr, wc, fr, fq); S.done(cur); }
        if (!has_next) break;
#pragma unroll
        for (int a = 0; a < 2; ++a)
#pragma unroll
            for (int b = 0; b < 2; ++b)
#pragma unroll
                for (int m = 0; m < 4; ++m)
#pragma unroll
                    for (int n = 0; n < 2; ++n) acc[a][b][m][n] = (f32x4){0.f, 0.f, 0.f, 0.f};
        cur = nxt; cA = nA; cB = nB; ++ui;
        if constexpr (ALIGN_EPI) { if (wr == 1) PG8_BAR; }
    }
    PG8_WAIT_V(0);
    if constexpr (!ALIGN_EPI) { if (wr == 0) PG8_BAR; }
    PG8_BAR;
    if constexpr (Epi::AFTER_DRAIN) { E.fused(acc, cur, wr, wc, fr, fq, lds, wid, lane); S.done(cur); }
#undef PG8_AROW
#undef PG8_SA
#undef PG8_SB
#undef PG8_STAGE
#undef PG8_LDA
#undef PG8_LDB
#undef PG8_MMA
#undef PG8_WAIT_V
#undef PG8_WAIT_L
#undef PG8_BAR
#undef PG8_SCHED
}
}
namespace sba {
#define SBA_LAS __attribute__((address_space(3)))
typedef unsigned short bf16;
using bf16x8 = __attribute__((ext_vector_type(8))) short;
using s16x4 = __attribute__((ext_vector_type(4))) short;
using f32x16 = __attribute__((ext_vector_type(16))) float;
using u32x4 = __attribute__((ext_vector_type(4))) unsigned;
constexpr int AT = 4096, AD = 1024, AMROW = 16384;
constexpr int SLOTB = 8192, LDS_K = 0, LDS_V = 3 * SLOTB, LDS_OST = 6 * SLOTB;
__device__ __forceinline__ int crow(int r, int hi) { return (r & 3) + 8 * (r >> 2) + 4 * hi; }
__device__ __forceinline__ void glds16(const void* gsrc, unsigned lds_dst) { unsigned keep;
    asm volatile("s_mov_b32 %0, m0\n\ts_mov_b32 m0, %2\n\ts_nop 0\n\tglobal_load_lds_dwordx4 %1, off\n\ts_mov_b32 m0, %0" : "=&s"(keep) : "v"(gsrc), "s"(lds_dst) : "memory"); }
typedef float f32x2_t __attribute__((ext_vector_type(2))); typedef __bf16 bf16x2_t __attribute__((ext_vector_type(2)));
__device__ __forceinline__ unsigned cvtpk_s(float lo, float hi) { f32x2_t v = {lo, hi}; bf16x2_t b = __builtin_convertvector(v, bf16x2_t); return __builtin_bit_cast(unsigned, b); }
__device__ __forceinline__ float fmul_s(float a, float b) { float r = a * b; asm("" : "+v"(r)); return r; }
__device__ __forceinline__ float fsub_s(float a, float b) { float r = a - b; asm("" : "+v"(r)); return r; }
__device__ __forceinline__ float fadd_s(float a, float b) { float r = a + b; asm("" : "+v"(r)); return r; }
#define SBA_WAIT_BAR(N) asm volatile("s_waitcnt vmcnt(" #N ") lgkmcnt(0)\n\ts_barrier" ::: "memory")
__device__ __forceinline__ void pv(f32x16* o, int vb, bf16x8 pa0, bf16x8 pa1, bf16x8 pa2, bf16x8 pa3) {
#pragma unroll
    for (int d0 = 0; d0 < 2; ++d0) { s16x4 lo[4], hi[4];
#pragma unroll
        for (int ks = 0; ks < 4; ++ks) {
            asm volatile("ds_read_b64_tr_b16 %0,%1 offset:%c2" : "=&v"(lo[ks]) : "v"(vb), "i"(d0 * 4096 + ks * 1024) : "memory");
            asm volatile("ds_read_b64_tr_b16 %0,%1 offset:%c2" : "=&v"(hi[ks]) : "v"(vb), "i"(d0 * 4096 + ks * 1024 + 512) : "memory"); }
        asm volatile("s_waitcnt lgkmcnt(0)" ::: "memory"); __builtin_amdgcn_sched_barrier(0);
#define SBA_PK(k) (bf16x8){lo[k][0], lo[k][1], lo[k][2], lo[k][3], hi[k][0], hi[k][1], hi[k][2], hi[k][3]}
        o[d0] = __builtin_amdgcn_mfma_f32_32x32x16_bf16(pa0, SBA_PK(0), o[d0], 0, 0, 0);
        o[d0] = __builtin_amdgcn_mfma_f32_32x32x16_bf16(pa1, SBA_PK(1), o[d0], 0, 0, 0);
        o[d0] = __builtin_amdgcn_mfma_f32_32x32x16_bf16(pa2, SBA_PK(2), o[d0], 0, 0, 0);
        o[d0] = __builtin_amdgcn_mfma_f32_32x32x16_bf16(pa3, SBA_PK(3), o[d0], 0, 0, 0);
#undef SBA_PK
    }
}
template <bool MASK>
__device__ __forceinline__ void tile(f32x16 (&o)[2], float& R, const bf16x8 (&qr)[4], SBA_LAS const unsigned char* kslot, int vb, int r32, int hi, int lim) {
    SBA_LAS const unsigned char* kb = kslot + hi * 1024 + r32 * 16;
    f32x16 p0 = {}, p1 = {};
#pragma unroll
    for (int d0 = 0; d0 < 4; ++d0) {
        const bf16x8 b0 = *(SBA_LAS const bf16x8*)(kb + d0 * 2048);
        const bf16x8 b1 = *(SBA_LAS const bf16x8*)(kb + d0 * 2048 + 512);
        p0 = __builtin_amdgcn_mfma_f32_32x32x16_bf16(b0, qr[d0], p0, 0, 0, 0);
        p1 = __builtin_amdgcn_mfma_f32_32x32x16_bf16(b1, qr[d0], p1, 0, 0, 0);
    }
    const int limh = lim - 4 * hi;
#pragma unroll
    for (int r = 0; r < 16; ++r) {
        float a0 = __builtin_amdgcn_rcpf(fadd_s(__builtin_amdgcn_exp2f(p0[r]), 1.0f)), a1 = __builtin_amdgcn_rcpf(fadd_s(__builtin_amdgcn_exp2f(p1[r]), 1.0f));
        if (MASK) { const int kv = (r & 3) + 8 * (r >> 2); a0 = (kv < limh) ? a0 : 1.0f; a1 = (kv + 32 < limh) ? a1 : 1.0f; }
        p0[r] = a0; p1[r] = a1;
    }
    float tl[8], th[8];
#pragma unroll
    for (int I = 0; I < 8; ++I) {
        const float t = (I < 4) ? fmul_s(fmul_s(p0[4 * I], p0[4 * I + 1]), fmul_s(p0[4 * I + 2], p0[4 * I + 3])) : fmul_s(fmul_s(p1[4 * I - 16], p1[4 * I - 15]), fmul_s(p1[4 * I - 14], p1[4 * I - 13]));
        auto rr = __builtin_amdgcn_permlane32_swap(__float_as_uint(t), __float_as_uint(t), false, false);
        tl[I] = __uint_as_float(rr[0]); th[I] = __uint_as_float(rr[1]);
    }
#pragma unroll
    for (int I = 7; I >= 0; --I) {
        float E = fmul_s(R, hi ? 1.0f : th[I]);
        if (I < 4) {
#pragma unroll
            for (int c = 3; c >= 0; --c) { const float P = fmul_s(E, p0[4 * I + c]); p0[4 * I + c] = fsub_s(E, P); E = P; }
        } else {
#pragma unroll
            for (int c = 3; c >= 0; --c) { const float P = fmul_s(E, p1[4 * I - 16 + c]); p1[4 * I - 16 + c] = fsub_s(E, P); E = P; }
        }
        R = fmul_s(R, fmul_s(tl[I], th[I]));
    }
    u32x4 pw0, pw1, pw2, pw3;
    pw0 = (u32x4){cvtpk_s(p0[0], p0[1]), cvtpk_s(p0[2], p0[3]), cvtpk_s(p0[4], p0[5]), cvtpk_s(p0[6], p0[7])};
    pw1 = (u32x4){cvtpk_s(p0[8], p0[9]), cvtpk_s(p0[10], p0[11]), cvtpk_s(p0[12], p0[13]), cvtpk_s(p0[14], p0[15])};
    pw2 = (u32x4){cvtpk_s(p1[0], p1[1]), cvtpk_s(p1[2], p1[3]), cvtpk_s(p1[4], p1[5]), cvtpk_s(p1[6], p1[7])};
    pw3 = (u32x4){cvtpk_s(p1[8], p1[9]), cvtpk_s(p1[10], p1[11]), cvtpk_s(p1[12], p1[13]), cvtpk_s(p1[14], p1[15])};
    __builtin_amdgcn_sched_barrier(0);
    pv(o, vb, __builtin_bit_cast(bf16x8, pw0), __builtin_bit_cast(bf16x8, pw1), __builtin_bit_cast(bf16x8, pw2), __builtin_bit_cast(bf16x8, pw3));
}
template <bool MASK>
__device__ __forceinline__ void tile32(f32x16 (&o)[2], float& R, const bf16x8 (&qr)[4], SBA_LAS const unsigned char* kimg, int vb, int r32, int hi, int lim) {
    SBA_LAS const unsigned char* kb = kimg + hi * 512 + r32 * 16;
    f32x16 p0 = {};
#pragma unroll
    for (int d0 = 0; d0 < 4; ++d0) { const bf16x8 b0 = *(SBA_LAS const bf16x8*)(kb + d0 * 1024); p0 = __builtin_amdgcn_mfma_f32_32x32x16_bf16(b0, qr[d0], p0, 0, 0, 0); }
    const int limh = lim - 4 * hi;
#pragma unroll
    for (int r = 0; r < 16; ++r) { float a0 = __builtin_amdgcn_rcpf(fadd_s(__builtin_amdgcn_exp2f(p0[r]), 1.0f));
        if (MASK) { const int kv = (r & 3) + 8 * (r >> 2); a0 = (kv < limh) ? a0 : 1.0f; }
        p0[r] = a0; }
    float tl[4], th[4];
#pragma unroll
    for (int I = 0; I < 4; ++I) { const float t = fmul_s(fmul_s(p0[4 * I], p0[4 * I + 1]), fmul_s(p0[4 * I + 2], p0[4 * I + 3]));
        auto rr = __builtin_amdgcn_permlane32_swap(__float_as_uint(t), __float_as_uint(t), false, false);
        tl[I] = __uint_as_float(rr[0]); th[I] = __uint_as_float(rr[1]); }
#pragma unroll
    for (int I = 3; I >= 0; --I) { float E = fmul_s(R, hi ? 1.0f : th[I]);
#pragma unroll
        for (int c = 3; c >= 0; --c) { const float P = fmul_s(E, p0[4 * I + c]); p0[4 * I + c] = fsub_s(E, P); E = P; }
        R = fmul_s(R, fmul_s(tl[I], th[I])); }
    const u32x4 pw0 = (u32x4){cvtpk_s(p0[0], p0[1]), cvtpk_s(p0[2], p0[3]), cvtpk_s(p0[4], p0[5]), cvtpk_s(p0[6], p0[7])};
    const u32x4 pw1 = (u32x4){cvtpk_s(p0[8], p0[9]), cvtpk_s(p0[10], p0[11]), cvtpk_s(p0[12], p0[13]), cvtpk_s(p0[14], p0[15])};
    __builtin_amdgcn_sched_barrier(0);
#pragma unroll
    for (int d0 = 0; d0 < 2; ++d0) { s16x4 lo[2], hh[2];
#pragma unroll
        for (int ks = 0; ks < 2; ++ks) {
            asm volatile("ds_read_b64_tr_b16 %0,%1 offset:%c2" : "=&v"(lo[ks]) : "v"(vb), "i"(d0 * 2048 + ks * 1024) : "memory");
            asm volatile("ds_read_b64_tr_b16 %0,%1 offset:%c2" : "=&v"(hh[ks]) : "v"(vb), "i"(d0 * 2048 + ks * 1024 + 512) : "memory"); }
        asm volatile("s_waitcnt lgkmcnt(0)" ::: "memory"); __builtin_amdgcn_sched_barrier(0);
        o[d0] = __builtin_amdgcn_mfma_f32_32x32x16_bf16(__builtin_bit_cast(bf16x8, pw0), (bf16x8){lo[0][0], lo[0][1], lo[0][2], lo[0][3], hh[0][0], hh[0][1], hh[0][2], hh[0][3]}, o[d0], 0, 0, 0);
        o[d0] = __builtin_amdgcn_mfma_f32_32x32x16_bf16(__builtin_bit_cast(bf16x8, pw1), (bf16x8){lo[1][0], lo[1][1], lo[1][2], lo[1][3], hh[1][0], hh[1][1], hh[1][2], hh[1][3]}, o[d0], 0, 0, 0);
    }
}
template <bool META>
__device__ __forceinline__ void wave_unit(int b, int h, int i32, const bf16* Q, const bf16* __restrict__ K, const bf16* __restrict__ V, bf16* O, SBA_LAS unsigned char* wbuf) {
    int tid = threadIdx.x; asm volatile("" : "+v"(tid));
    const int lane = tid & 63, r32 = lane & 31, hi = lane >> 5;
    const size_t rowbase = (size_t)b * AT;
    const size_t qrow0 = META ? (size_t)AMROW : rowbase + 32 * i32;
    const bf16* Qw = Q + qrow0 * AD + h * 64;
    const unsigned lds0 = (unsigned)(uintptr_t)wbuf;
    const bf16* ksrc = K + h * 64 + (size_t)(lane & 31) * AD + (lane >> 5) * 8;
    const bf16* vsrc = V + h * 64 + (size_t)(lane >> 2) * AD + (lane & 3) * 8;
    bf16x8 qr[4];
#pragma unroll
    for (int d0 = 0; d0 < 4; ++d0) qr[d0] = *(const bf16x8*)(Qw + (size_t)r32 * AD + d0 * 16 + hi * 8);
    f32x16 o[2]; o[0] = f32x16{}; o[1] = f32x16{};
    float R = 1.0f;
    const int tmin = 32 * i32, tmax = tmin + 31, tq = tmin + r32;
    const int vb0 = (int)(lds0 + 4096) + ((lane >> 4) & 1) * 32 + (lane & 3) * 8 + (4 * hi + ((lane & 15) >> 2)) * 64;
#define SBA_DMA32(j_, bf_) do { const size_t r_ = ((j_) >= 0) ? rowbase + (size_t)32 * (j_) : (size_t)AMROW; const unsigned d_ = lds0 + (unsigned)(bf_) * 8192u; \
        _Pragma("unroll") for (int i = 0; i < 4; ++i) glds16(ksrc + r_ * AD + i * 16, (unsigned)__builtin_amdgcn_readfirstlane(d_ + i * 1024)); \
        _Pragma("unroll") for (int p = 0; p < 4; ++p) glds16(vsrc + (r_ + 16 * (p & 1)) * AD + (p >> 1) * 32, (unsigned)__builtin_amdgcn_readfirstlane(d_ + 4096 + p * 1024)); } while (0)
    const int jtop = META ? -1 : ((tmax - 1) >> 5);
    SBA_DMA32(jtop, 0);
    if (jtop >= 0) SBA_DMA32(jtop - 1, 1);
    int bf = 0;
    for (int j = jtop; j >= -1; --j) {
        if (j >= 0) asm volatile("s_waitcnt vmcnt(8)" ::: "memory"); else asm volatile("s_waitcnt vmcnt(0)" ::: "memory");
        SBA_LAS const unsigned char* kimg = wbuf + bf * 8192; const int vb = vb0 + bf * 8192;
        if (j < 0) tile32<true>(o, R, qr, kimg, vb, r32, hi, META ? (r32 < 16 ? r32 : 16) : 16);
        else if (32 * j + 31 >= tmin) tile32<true>(o, R, qr, kimg, vb, r32, hi, tq - 32 * j);
        else tile32<false>(o, R, qr, kimg, vb, r32, hi, 32);
        if (__all(R == 0.0f)) break;
        asm volatile("s_waitcnt lgkmcnt(0)" ::: "memory");
        if (j >= 1) SBA_DMA32(j - 2, bf);
        bf ^= 1;
    }
#undef SBA_DMA32
    bf16* Ow = O + qrow0 * AD + h * 64;
    asm volatile("s_waitcnt vmcnt(0) lgkmcnt(0)" ::: "memory");
    { SBA_LAS bf16* stg = (SBA_LAS bf16*)wbuf;
#pragma unroll
      for (int r = 0; r < 16; ++r) { const int orow = crow(r, hi);
#pragma unroll
          for (int d0 = 0; d0 < 2; ++d0) stg[orow * 64 + d0 * 32 + r32] = (bf16)(cvtpk_s(o[d0][r], 0.f) & 0xffffu); }
      asm volatile("s_waitcnt lgkmcnt(0)" ::: "memory");
#pragma unroll
      for (int i = 0; i < 4; ++i) { const int row = i * 8 + (lane >> 3), ch = lane & 7; const u32x4 v = *(SBA_LAS const u32x4*)(stg + row * 64 + ch * 8); __builtin_nontemporal_store(v, (u32x4*)(Ow + (size_t)row * AD + ch * 8)); } }
    asm volatile("s_waitcnt vmcnt(0) lgkmcnt(0)" ::: "memory");
}
__device__ __forceinline__ void phase(SBA_LAS unsigned char* shm, const bf16* Q, const bf16* K, const bf16* V, bf16* O, int G, int bx) {
    const int vcu = (G % 8 == 0) ? (bx % 8) * (G / 8) + bx / 8 : bx;
    const int wid = __builtin_amdgcn_readfirstlane(threadIdx.x >> 6), gwv = vcu * 8 + wid, NGWV = G * 8;
    SBA_LAS unsigned char* wbuf = shm + wid * 16384;
    for (int u = gwv; u < 64 * 128; u += NGWV) { const int bh = u >> 7, i32 = 127 - (u & 127); wave_unit<false>(bh >> 4, bh & 15, i32, Q, K, V, O, wbuf); }
    for (int hm = NGWV - 1 - gwv; hm < 16; hm += NGWV) wave_unit<true>(0, hm, 0, Q, K, V, O, wbuf);
    __syncthreads();
}
}

#ifndef MK_N_LAUNCHES
#define MK_N_LAUNCHES 1
#endif
#ifndef PROBE_A
#define PROBE_A -1
#define PROBE_B -1
#endif
#ifndef ATTN_SIMPLE
#define ATTN_SIMPLE 0
#endif
constexpr int NB = 4, T = 4096, D = 1024, NMETA = 16, NH = 16, HD = 64, FF = 2816, FF2 = 5632;
constexpr int M = NB * T;
constexpr int MROW = M;
constexpr int MR = M + 64;
constexpr float EPS = 1e-6f;
constexpr float C2 = 0.125f * 1.4426950408889634f;
constexpr int NWAVES = 8, NTHREADS = 512, NPHASES = 11;
constexpr size_t WS_WPOOL = 0;
constexpr size_t WS_WUP   = WS_WPOOL + (size_t)4 * 256 * 256 * 2;
constexpr size_t WS_WDOWN = WS_WUP + (size_t)2 * FF2 * D * 2;
constexpr size_t WS_WQKV  = WS_WDOWN + (size_t)2 * D * FF * 2;
constexpr size_t WS_WO    = WS_WQKV + (size_t)3 * D * D * 2;
constexpr size_t WS_HB    = WS_WO + (size_t)D * D * 2;
constexpr size_t WS_U     = WS_HB + (size_t)MR * D * 2;
constexpr size_t WS_HALO  = WS_U + (size_t)MR * FF2 * 2;
constexpr size_t WS_SSQ   = WS_HALO + (size_t)65 * 2 * FF2 * 2;
constexpr size_t WS_HM    = WS_SSQ + (size_t)5 * MR * 4;
constexpr size_t WS_CTL   = WS_HM + (size_t)16 * D * 4;
constexpr size_t CTL_BYTES = 16384;
constexpr size_t WS_END   = WS_CTL + CTL_BYTES;
constexpr size_t ACT_BYTES = (size_t)MR * D * 2;
static_assert(WS_END <= 268435456, "workspace map exceeds 256 MiB");
static_assert(4 * ACT_BYTES <= (size_t)MR * FF2 * 2, "Q|K|V|O overlay fits in U");
constexpr int LDS_MISC_OFF = 131072;
constexpr int LDS_BYTES = 147456;

#define GAS __attribute__((address_space(1)))
#define LAS __attribute__((address_space(3)))
typedef unsigned short bf16;
typedef unsigned v4u __attribute__((ext_vector_type(4)));
typedef unsigned v2u __attribute__((ext_vector_type(2)));
typedef float f32x4 __attribute__((ext_vector_type(4)));
typedef short bf16x8 __attribute__((ext_vector_type(8)));
#define LDS_WAIT() asm volatile("s_waitcnt lgkmcnt(0)" ::: "memory")
__device__ __forceinline__ unsigned pk2(float lo, float hi) { return pg8::cvt_pk_bf16(lo, hi); }
__device__ __forceinline__ float bflo(unsigned w) { return __uint_as_float(w << 16); }
__device__ __forceinline__ float bfhi(unsigned w) { return __uint_as_float(w & 0xffff0000u); }
__device__ __forceinline__ float wave_sum(float v) {
#pragma unroll
    for (int o = 1; o < 64; o <<= 1) v += __shfl_xor(v, o);
    return v;
}
__device__ __forceinline__ float rs_of(float ssq) { return __builtin_amdgcn_rsqf(ssq * (1.0f / (float)D) + EPS); }

#define RLX_AGENT __ATOMIC_RELAXED, __HIP_MEMORY_SCOPE_AGENT
#define XB_TMO      128
#define XB_XCNT(j)  (256  + 64 * (j))
#define XB_XSUB(j)  (1280 + 64 * (j))
#define XB_XGEN(j)  (2304 + 64 * (j))
#define XB_TOP      3328
#define XB_TOPGEN   3392
#define XCD_BAR_WORDS 3456
#define XB_SPIN_CAP (1u << 18)

__device__ __forceinline__ unsigned xb_ld(unsigned* p)              { return __hip_atomic_load(p, __ATOMIC_RELAXED, __HIP_MEMORY_SCOPE_AGENT); }
__device__ __forceinline__ unsigned xb_add(unsigned* p, unsigned v) { return __hip_atomic_fetch_add(p, v, __ATOMIC_RELAXED, __HIP_MEMORY_SCOPE_AGENT); }
__device__ __forceinline__ unsigned xb_xcc_id() { return (unsigned)__builtin_amdgcn_s_getreg((3 << 11) | 20) & 0xFu; }
#define XB_SPIN(cond, bar) do { unsigned _sp = 0; while (cond) { __builtin_amdgcn_s_sleep(1); \
    if ((++_sp & 255u) == 0u) { if (xb_ld(&(bar)[XB_TMO])) break; if (_sp > XB_SPIN_CAP) { atomicAdd(&(bar)[XB_TMO], 1u); break; } } } } while (0)

struct XcdBarrier {
    unsigned* bar; unsigned x;
    volatile LAS unsigned* st;
};

__device__ __forceinline__ XcdBarrier xcd_barrier_post(unsigned* bar, volatile LAS unsigned* st) {
    XcdBarrier b; b.bar = bar; b.x = xb_xcc_id(); b.st = st;
    if (threadIdx.x == 0) (void)xb_add(&bar[XB_XCNT(b.x)], 1u);
    return b;
}
__device__ __forceinline__ void xcd_barrier_complete(unsigned* bar, unsigned x, unsigned& nloc, unsigned& nx) {
    const unsigned G = gridDim.x * gridDim.y * gridDim.z;
    unsigned sum, cnt, mine, sp = 0u;
    for (;;) {
        sum = 0u; cnt = 0u; mine = 0u;
#pragma unroll
        for (unsigned j = 0; j < 16; ++j) { const unsigned c = xb_ld(&bar[XB_XCNT(j)]); sum += c; cnt += (c > 0u) ? 1u : 0u; mine = (j == x) ? c : mine; }
        if (sum == G) break;
        __builtin_amdgcn_s_sleep(1);
        if ((++sp & 255u) == 0u) { if (xb_ld(&bar[XB_TMO])) break; if (sp > XB_SPIN_CAP) { atomicAdd(&bar[XB_TMO], 1u); break; } }
    }
    nloc = mine > 0u ? mine : 1u; nx = cnt > 0u ? cnt : 1u;
}

__device__ __forceinline__ void xcd_barrier(const XcdBarrier& b) {
    asm volatile("s_waitcnt vmcnt(0)" ::: "memory");
    __syncthreads();
    if (threadIdx.x == 0) {
        unsigned* bar = b.bar;
        __builtin_amdgcn_s_waitcnt(0);
        unsigned nloc = b.st[0], nx = b.st[1];
        if (nloc == 0u) { xcd_barrier_complete(bar, b.x, nloc, nx); b.st[0] = nloc; b.st[1] = nx; }
        const unsigned old = xb_add(&bar[XB_XSUB(b.x)], 1u);
        const unsigned gen = old / nloc;
        if (old + 1u == (gen + 1u) * nloc) {
            __builtin_amdgcn_fence(__ATOMIC_RELEASE, "agent");
            asm volatile("s_waitcnt vmcnt(0)" ::: "memory");
            const unsigned og = xb_add(&bar[XB_TOP], 1u);
            const unsigned tg = og / nx;
            if (og + 1u == (tg + 1u) * nx) xb_add(&bar[XB_TOPGEN], 1u);
            else XB_SPIN(xb_ld(&bar[XB_TOPGEN]) == tg, bar);
            __builtin_amdgcn_fence(__ATOMIC_ACQUIRE, "agent");
            xb_add(&bar[XB_XGEN(b.x)], 1u);
            asm volatile("s_waitcnt vmcnt(0)" ::: "memory");
        } else {
            XB_SPIN(xb_ld(&bar[XB_XGEN(b.x)]) == gen, bar);
            __builtin_amdgcn_fence(__ATOMIC_ACQUIRE, "agent");
            asm volatile("s_waitcnt vmcnt(0)" ::: "memory");
        }
    }
    __syncthreads();
}


__device__ __forceinline__ void p0_transpose_item(const float* W, int K, int N, bf16* WT, int row_off, const float* gain, LAS float* scr, int item, int lane) {
    const int nblk = N / 32, kb = item / nblk, nb = item % nblk, k0 = 64 * kb, n0 = 32 * nb;
    const int c4 = (lane & 7) * 4;
    f32x4 w[8];
#pragma unroll
    for (int i = 0; i < 8; ++i) { const int kk = 8 * i + (lane >> 3); w[i] = __builtin_nontemporal_load((const f32x4*)(W + (size_t)(k0 + kk) * N + n0 + c4)); }
#pragma unroll
    for (int i = 0; i < 8; ++i) { const int kk = 8 * i + (lane >> 3); const float gk = gain ? gain[k0 + kk] : 1.f; LAS float* d = scr + kk * 33 + c4;
        d[0] = w[i][0] * gk; d[1] = w[i][1] * gk; d[2] = w[i][2] * gk; d[3] = w[i][3] * gk; }
    LDS_WAIT(); asm volatile("" ::: "memory");
    const int c = lane & 7;
#pragma unroll
    for (int j = 0; j < 4; ++j) { const int n = (lane >> 3) + 8 * j; const LAS float* s = scr + (8 * c) * 33 + n;
        v4u o; o.x = pk2(s[0 * 33], s[1 * 33]); o.y = pk2(s[2 * 33], s[3 * 33]); o.z = pk2(s[4 * 33], s[5 * 33]); o.w = pk2(s[6 * 33], s[7 * 33]);
        *(v4u*)(WT + (size_t)(row_off + n0 + n) * K + k0 + 8 * c) = o; }
    LDS_WAIT(); asm volatile("" ::: "memory");
}
template <bool IS_META, int NR>
__device__ __forceinline__ void p0_diff8(const float* __restrict__ x, const float* __restrict__ meta, const float* __restrict__ g0, const float* __restrict__ ssq0, bf16* __restrict__ DIFF, int b, int t0, int lane) {
    f32x4 gv[4];
#pragma unroll
    for (int j = 0; j < 4; ++j) gv[j] = *(const f32x4*)(g0 + 4 * lane + 256 * j);
    float myrs = 0.f;
    { const int t = t0 - 15 + lane; if (lane < 15 + NR && t >= -16) myrs = rs_of(ssq0[(t >= 0) ? (b * T + t) : (M + 16 + t)]); }
#define P0_RS(dt) __builtin_bit_cast(float, __builtin_amdgcn_readlane(__builtin_bit_cast(int, myrs), 15 + (dt)))
#define P0_SRC(t_) (((t_) >= 0) ? x + ((size_t)b * T + (t_)) * D : meta + (size_t)(16 + (t_)) * D)
    const f32x4 z4 = {0.f, 0.f, 0.f, 0.f};
    f32x4 S[4];
#pragma unroll
    for (int j = 0; j < 4; ++j) { S[j] = z4; const int w = 2 << j;
#pragma unroll
        for (int i = 1; i < w; ++i) { const int t = t0 - i; if (!IS_META || t >= -16) S[j] += *(const f32x4*)(P0_SRC(t) + 4 * lane + 256 * j) * (P0_RS(-i) * gv[j]); } }
#pragma unroll
    for (int r = 0; r < NR; ++r) {
        const int t = t0 + r; const float* src = P0_SRC(t); const float rs = P0_RS(r);
        const size_t orow = IS_META ? (size_t)(M + 16 + t) : ((size_t)b * T + t);
#pragma unroll
        for (int j = 0; j < 4; ++j) { const int w = 2 << j;
            const f32x4 n = *(const f32x4*)(src + 4 * lane + 256 * j) * (rs * gv[j]);
            S[j] += n;
            const int pos1 = t + 17;
            const float inv = IS_META ? 1.0f / (float)(pos1 < w ? pos1 : w) : 1.0f / (float)w;
            const f32x4 d = S[j] * inv - n; v2u o; o.x = pk2(d[0], d[1]); o.y = pk2(d[2], d[3]);
            *(v2u*)(DIFF + orow * D + 4 * lane + 256 * j) = o;
            const int to = t - w + 1;
            if (r < NR - 1 && (!IS_META || to >= -16)) S[j] -= *(const f32x4*)(P0_SRC(to) + 4 * lane + 256 * j) * (P0_RS(r - w + 1) * gv[j]);
        }
    }
#undef P0_RS
#undef P0_SRC
}
template <bool IS_META>
__device__ __forceinline__ void diff_block(const float* __restrict__ x, const float* __restrict__ meta, const float* __restrict__ g0, const float* __restrict__ ssq0, bf16* __restrict__ DIFF,
                                           int b, int t0, int j, LAS float* tile, int tid) {
    constexpr int NOUT = IS_META ? 16 : 64;
    const int w = 2 << j, tlo = IS_META ? t0 : t0 - (w - 1), nrows = IS_META ? NOUT : NOUT + w - 1;
    const int c4 = tid & 63, rp = tid >> 6;
    const f32x4 gv = *(const f32x4*)(g0 + 256 * j + 4 * c4);
#pragma unroll 5
    for (int lr = rp; lr < nrows; lr += 8) { const int t = tlo + lr;
        const float* src = (t >= 0) ? x + ((size_t)b * T + t) * D : meta + (size_t)(16 + t) * D;
        const float rs = rs_of(ssq0[(t >= 0) ? (b * T + t) : (M + 16 + t)]);
        *(LAS f32x4*)(tile + (size_t)lr * 256 + 4 * c4) = *(const f32x4*)(src + 256 * j + 4 * c4) * (rs * gv); }
    __syncthreads();
    if (rp * 8 < NOUT) {
        const int tf = t0 + 8 * rp; const f32x4 z4 = {0.f, 0.f, 0.f, 0.f}; f32x4 S = z4;
        for (int i = 1; i < w; ++i) { const int t = tf - i; if (t >= tlo) S += *(const LAS f32x4*)(tile + (size_t)(t - tlo) * 256 + 4 * c4); }
#pragma unroll
        for (int r = 0; r < 8; ++r) { const int t = tf + r; const f32x4 n = *(const LAS f32x4*)(tile + (size_t)(t - tlo) * 256 + 4 * c4);
            S += n;
            const int pos1 = t + 17; const float inv = IS_META ? 1.0f / (float)(pos1 < w ? pos1 : w) : 1.0f / (float)w;
            const f32x4 d = S * inv - n; v2u o; o.x = pk2(d[0], d[1]); o.y = pk2(d[2], d[3]);
            const size_t orow = IS_META ? (size_t)(M + 16 + t) : ((size_t)b * T + t);
            *(v2u*)(DIFF + orow * D + 256 * j + 4 * c4) = o;
            const int to = t - w + 1; if (to >= tlo) S -= *(const LAS f32x4*)(tile + (size_t)(to - tlo) * 256 + 4 * c4); }
    }
    __syncthreads();
}
template <class F>
__device__ __forceinline__ void thin_item(const bf16* A, int lda, const bf16* Bt, int K, int n0, int lane, int wave, LAS float* red, F epi) {
    const int m = lane & 15, kq = lane >> 4, kw = K / NWAVES;
    const bf16* ap = A + (size_t)m * lda + wave * kw + kq * 8; const bf16* bp = Bt + (size_t)(n0 + m) * K + wave * kw + kq * 8;
    f32x4 acc = {0.f, 0.f, 0.f, 0.f};
#pragma unroll 12
    for (int ks = 0; ks < kw; ks += 32) { const bf16x8 a = *(const bf16x8*)(ap + ks); const bf16x8 bb = *(const bf16x8*)(bp + ks); acc = __builtin_amdgcn_mfma_f32_16x16x32_bf16(a, bb, acc, 0, 0, 0); }
    *(LAS f32x4*)(red + (wave * 64 + lane) * 4) = acc;
    __syncthreads();
    if (wave == 0) {
        f32x4 sum = acc;
#pragma unroll
        for (int w = 1; w < NWAVES; ++w) sum += *(const LAS f32x4*)(red + (w * 64 + lane) * 4);
        epi(4 * kq, n0 + m, sum);
    }
    __syncthreads();
}
__device__ __forceinline__ void thin_res_epi(const float* base, float* hm, bf16* HB, float* ssq, const float* cscale, int row4, int col, const f32x4 acc) {
    const float cs = cscale ? cscale[col] : 1.f; float q[4];
#pragma unroll
    for (int i = 0; i < 4; ++i) { const int r = row4 + i; const float o = base[(size_t)r * D + col] + acc[i] * cs; hm[(size_t)r * D + col] = o; if (HB) { const bf16 ob = (bf16)(pk2(o, 0.f) & 0xffffu);
#pragma unroll
            for (int bb = 0; bb < NB; ++bb) HB[((size_t)bb * (T + 16) + r) * D + col] = ob; }          q[i] = o * o; }
#pragma unroll
    for (int i = 0; i < 4; ++i) { float s = q[i]; s += __shfl_xor(s, 1); s += __shfl_xor(s, 2); s += __shfl_xor(s, 4); s += __shfl_xor(s, 8); if ((col & 15) == 0) atomicAdd(ssq + MROW + row4 + i, s); }
}
__device__ __forceinline__ int upperm(int c) { return c < FF ? (c >> 7) * 256 + (c & 127) : ((c - FF) >> 7) * 256 + 128 + ((c - FF) & 127); }
__device__ __forceinline__ void thin_up_convgate(const bf16* A, const bf16* Wt, const float* ssq_in, const float* cw, const float* cb, bf16* GM, int it, int lane, int wave, LAS float* red) {
    const int m = lane & 15, kq = lane >> 4, kw = D / NWAVES, j0 = 16 * it;
    const bf16* ap = A + (size_t)m * D + wave * kw + kq * 8;
    const bf16* bg_ = Wt + (size_t)(upperm(j0) + m) * D + wave * kw + kq * 8; const bf16* bv_ = Wt + (size_t)(upperm(FF + j0) + m) * D + wave * kw + kq * 8;
    f32x4 ag = {0.f, 0.f, 0.f, 0.f}, av = {0.f, 0.f, 0.f, 0.f};
#pragma unroll
    for (int ks = 0; ks < kw; ks += 32) { const bf16x8 a = *(const bf16x8*)(ap + ks);
        ag = __builtin_amdgcn_mfma_f32_16x16x32_bf16(a, *(const bf16x8*)(bg_ + ks), ag, 0, 0, 0); av = __builtin_amdgcn_mfma_f32_16x16x32_bf16(a, *(const bf16x8*)(bv_ + ks), av, 0, 0, 0); }
    *(LAS f32x4*)(red + (wave * 64 + lane) * 8) = ag; *(LAS f32x4*)(red + (wave * 64 + lane) * 8 + 4) = av;
    __syncthreads();
    if (wave == 0) {
#pragma unroll
        for (int w = 1; w < NWAVES; ++w) { ag += *(const LAS f32x4*)(red + (w * 64 + lane) * 8); av += *(const LAS f32x4*)(red + (w * 64 + lane) * 8 + 4); }
        const int ch = j0 + m; float ug[4], uv[4];
#pragma unroll
        for (int i = 0; i < 4; ++i) { const float rs = rs_of(ssq_in[MROW + 4 * kq + i]); ug[i] = ag[i] * rs; uv[i] = av[i] * rs; }
        float h1g = __shfl_up(ug[3], 16), h2g = __shfl_up(ug[2], 16), h1v = __shfl_up(uv[3], 16), h2v = __shfl_up(uv[2], 16);
        if (kq == 0) { h1g = 0.f; h2g = 0.f; h1v = 0.f; h2v = 0.f; }
        const float wg0 = cw[ch], wg1 = cw[FF2 + ch], wg2 = cw[2 * FF2 + ch], bgc = cb[ch], wv0 = cw[FF + ch], wv1 = cw[FF2 + FF + ch], wv2 = cw[2 * FF2 + FF + ch], bvc = cb[FF + ch];
#pragma unroll
        for (int i = 0; i < 4; ++i) {
            const float p1g = i >= 1 ? ug[i - 1] : h1g, p2g = i >= 2 ? ug[i - 2] : (i == 1 ? h1g : h2g), p1v = i >= 1 ? uv[i - 1] : h1v, p2v = i >= 2 ? uv[i - 2] : (i == 1 ? h1v : h2v);
            const float gc = bgc + wg0 * p2g + wg1 * p1g + wg2 * ug[i], vc = bvc + wv0 * p2v + wv1 * p1v + wv2 * uv[i];
            const float o = gc * __builtin_amdgcn_rcpf(1.0f + __builtin_amdgcn_exp2f(-1.4426950408889634f * gc)) * vc;
            GM[(size_t)(4 * kq + i) * FF + ch] = (bf16)(pk2(o, 0.f) & 0xffffu);
        }
    }
    __syncthreads();
}
struct ConvW { float wg[3][8], bg[8], wv[3][8], bv[8]; };
__device__ __forceinline__ void unpack8(const v4u w, float (&f)[8]) { f[0] = bflo(w.x); f[1] = bfhi(w.x); f[2] = bflo(w.y); f[3] = bfhi(w.y); f[4] = bflo(w.z); f[5] = bfhi(w.z); f[6] = bflo(w.w); f[7] = bfhi(w.w); }
__device__ __forceinline__ void convgate_walk(bf16* U, int row0, int nrows, int ch, const float* cw, const float* cb, v4u pg2, v4u pv2, v4u pg1, v4u pv1) {
    float wg[3][8], wv[3][8], bg[8], bv[8];
#pragma unroll
    for (int k = 0; k < 3; ++k)
#pragma unroll
        for (int i = 0; i < 8; ++i) { wg[k][i] = cw[k * FF2 + ch + i]; wv[k][i] = cw[k * FF2 + FF + ch + i]; }
#pragma unroll
    for (int i = 0; i < 8; ++i) { bg[i] = cb[ch + i]; bv[i] = cb[FF + ch + i]; }
    float g2[8], v2[8], g1[8], v1[8];
    unpack8(pg2, g2); unpack8(pv2, v2); unpack8(pg1, g1); unpack8(pv1, v1);
    bf16* p = U + (size_t)row0 * FF2 + ch;
    for (int r0 = 0; r0 < nrows; r0 += 4, p += 4 * FF2) {
        v4u ug[4], uv[4];
#pragma unroll
        for (int q = 0; q < 4; ++q) { ug[q] = *(const v4u*)(p + (size_t)q * FF2); uv[q] = *(const v4u*)(p + (size_t)q * FF2 + FF); }
#pragma unroll
        for (int q = 0; q < 4; ++q) {
            float g0[8], v0[8], o[8]; unpack8(ug[q], g0); unpack8(uv[q], v0);
#pragma unroll
            for (int i = 0; i < 8; ++i) {
                const float gc = bg[i] + wg[0][i] * g2[i] + wg[1][i] * g1[i] + wg[2][i] * g0[i];
                const float vc = bv[i] + wv[0][i] * v2[i] + wv[1][i] * v1[i] + wv[2][i] * v0[i];
                const float sg = gc * __builtin_amdgcn_rcpf(1.0f + __builtin_amdgcn_exp2f(-1.4426950408889634f * gc));
                o[i] = sg * vc; g2[i] = g1[i]; v2[i] = v1[i]; g1[i] = g0[i]; v1[i] = v0[i];
            }
            v4u w; w.x = pk2(o[0], o[1]); w.y = pk2(o[2], o[3]); w.z = pk2(o[4], o[5]); w.w = pk2(o[6], o[7]);
            *(v4u*)(p + (size_t)q * FF2) = w;
        }
    }
}
__device__ __forceinline__ void convgate_phase(bf16* U, const bf16* HALO, const float* cw, const float* cb, int G, int tid) {
    const v4u z = {0u, 0u, 0u, 0u};
    for (int item = blockIdx.x; item < 256; item += G) {
        const int pm = item >> 2, cq = item & 3, rq = tid / 88, cv = tid % 88, ch = 704 * cq + 8 * cv, row0 = 256 * pm + 64 * rq;
        v4u pg2 = z, pv2 = z, pg1 = z, pv1 = z;
        if (tid < 352) {
            const bf16* h2; const bf16* h1;
            if (rq > 0) { h2 = U + (size_t)(row0 - 2) * FF2; h1 = h2 + FF2; }
            else { const int slot = (pm % 16 == 0) ? 64 : pm - 1; h2 = HALO + (size_t)slot * 2 * FF2; h1 = h2 + FF2; }
            pg2 = *(const v4u*)(h2 + ch); pv2 = *(const v4u*)(h2 + FF + ch); pg1 = *(const v4u*)(h1 + ch); pv1 = *(const v4u*)(h1 + FF + ch);
        }
        __syncthreads();
        if (tid < 352) convgate_walk(U, row0, 64, ch, cw, cb, pg2, pv2, pg1, pv1);
        __syncthreads();
    }
    if (blockIdx.x == G - 1 && tid < 352) convgate_walk(U, MROW, 16, 8 * tid, cw, cb, z, z, z, z);
}
__device__ __forceinline__ void attn_simple(const bf16* Q, const bf16* K, const bf16* V, bf16* O, int first, int nblk, int brank, int tid) {
    const int total = NB * NH * T + NH * NMETA;
    for (int base = first + brank * NTHREADS; base < total; base += nblk * NTHREADS) {
        const int idx = base + tid; const bool valid = idx < total;
        int b = 0, h = 0, npos = 0; size_t qrow = 0;
        if (valid) { if (idx < NB * NH * T) { b = idx / (NH * T); h = (idx / T) % NH; const int t = idx % T; qrow = (size_t)b * T + t; npos = NMETA + t; }
                     else { const int mi = idx - NB * NH * T; h = mi / NMETA; const int t = mi % NMETA; qrow = (size_t)MROW + t; npos = t; } }
        float q[64], o[64];
#pragma unroll
        for (int c = 0; c < 8; ++c) { const v4u w = *(const v4u*)(Q + qrow * D + h * HD + 8 * c); float f[8]; unpack8(w, f);
#pragma unroll
            for (int i = 0; i < 8; ++i) { q[8 * c + i] = f[i]; o[8 * c + i] = 0.f; } }
        int pmax = npos;
#pragma unroll
        for (int s = 1; s < 64; s <<= 1) { const int other = __shfl_xor(pmax, s); pmax = other > pmax ? other : pmax; }
        float carry = 1.f;
        for (int p = pmax - 1; p >= 0; --p) {
            const size_t krow = (p >= NMETA) ? ((size_t)b * T + (p - NMETA)) : (size_t)(MROW + p);
            const bf16* kp = K + krow * D + h * HD; const bf16* vp = V + krow * D + h * HD;
            float z = 0.f;
#pragma unroll
            for (int c = 0; c < 8; ++c) { const v4u w = *(const v4u*)(kp + 8 * c); float f[8]; unpack8(w, f);
#pragma unroll
                for (int i = 0; i < 8; ++i) z += q[8 * c + i] * f[i]; }
            z = fminf(fmaxf(z, -80.f), 80.f);
            const float e = __builtin_amdgcn_exp2f(-z), r = __builtin_amdgcn_rcpf(1.0f + e);
            const bool act = p < npos;
            const float a = act ? r * carry : 0.f; carry = act ? carry * (e * r) : carry;
#pragma unroll
            for (int c = 0; c < 8; ++c) { const v4u w = *(const v4u*)(vp + 8 * c); float f[8]; unpack8(w, f);
#pragma unroll
                for (int i = 0; i < 8; ++i) o[8 * c + i] += a * f[i]; }
        }
        if (valid) {
#pragma unroll
            for (int c = 0; c < 8; ++c) { v4u w; w.x = pk2(o[8 * c], o[8 * c + 1]); w.y = pk2(o[8 * c + 2], o[8 * c + 3]); w.z = pk2(o[8 * c + 4], o[8 * c + 5]); w.w = pk2(o[8 * c + 6], o[8 * c + 7]);
                *(v4u*)(O + qrow * D + h * HD + 8 * c) = w; }
        }
    }
}

struct Args { const float* in[15]; float* out; unsigned char* ws; int ph_lo, ph_hi; };
__global__ void __launch_bounds__(NTHREADS, 2) yoco_fwd(Args args) {
    extern __shared__ __attribute__((aligned(16))) unsigned char lds_raw[];
    LAS unsigned char* lds = (LAS unsigned char*)lds_raw;
    cg::grid_group grid = cg::this_grid();
    asm volatile("s_nop 0");
    const int tid = threadIdx.x, lane = tid & 63, wave = __builtin_amdgcn_readfirstlane(tid >> 6);
    const int G = gridDim.x, bx = blockIdx.x;
    const int gw = bx * NWAVES + wave, NGW = G * NWAVES;
    const int tw = (G - 1 - bx) * NWAVES + wave;
    const float* x = args.in[0]; const float* meta = args.in[1]; const float* mix_norm = args.in[2]; const float* ffn_norm = args.in[3];
    const float* pool_w = args.in[4]; const float* pool_scale = args.in[5]; const float* kv_norm = args.in[6]; const float* w_kv = args.in[7];
    const float* w_q = args.in[8]; const float* w_o = args.in[9]; const float* w_up = args.in[10]; const float* conv_w = args.in[11];
    const float* conv_b = args.in[12]; const float* w_down = args.in[13]; const float* final_norm = args.in[14];
    float* out = args.out; unsigned char* ws = args.ws;
    bf16* Wpool_t = (bf16*)(ws + WS_WPOOL); bf16* Wup_t = (bf16*)(ws + WS_WUP); bf16* Wdown_t = (bf16*)(ws + WS_WDOWN); bf16* Wqkv_t = (bf16*)(ws + WS_WQKV); bf16* Wo_t = (bf16*)(ws + WS_WO);
    bf16* HB = (bf16*)(ws + WS_HB); bf16* U = (bf16*)(ws + WS_U); bf16* GM = (bf16*)(ws + WS_HALO);
    bf16* DIFF = U; bf16* QB = U; bf16* KB = (bf16*)(ws + WS_U + ACT_BYTES); bf16* VB = (bf16*)(ws + WS_U + 2 * ACT_BYTES); bf16* OB = (bf16*)(ws + WS_U + 3 * ACT_BYTES);
    float* SSQ = (float*)(ws + WS_SSQ); float* HM = (float*)(ws + WS_HM);
    float* ssq1 = SSQ, *ssq2 = SSQ + MR, *ssq3 = SSQ + 2 * MR, *ssq4 = SSQ + 3 * MR, *ssq0 = SSQ + 4 * MR;
    const int lo = args.ph_lo, hi = args.ph_hi;
#define IN(k) (lo <= (k) && (k) < hi)
#if PROBE_A >= 0
    unsigned long long tprev = __builtin_amdgcn_s_memrealtime(), dA = 0, dB = 0;
#define PROBE_MARK(k) do { if (bx == 0 && tid == 0) { const unsigned long long now_ = __builtin_amdgcn_s_memrealtime(); if ((k) == PROBE_A) dA = now_ - tprev; if ((k) == PROBE_B) dB = now_ - tprev; tprev = now_; } } while (0)
#else
#define PROBE_MARK(k) do { } while (0)
#endif
    volatile LAS unsigned* bst = (volatile LAS unsigned*)(lds + LDS_MISC_OFF);
    if (tid < 2) bst[tid] = 0u;
    __syncthreads();
    XcdBarrier bar = xcd_barrier_post((unsigned*)(ws + WS_CTL), bst);
    if (lo < 0) grid.sync();
#define SEAM(k) do { if (IN(k) && IN((k) + 1)) xcd_barrier(bar); PROBE_MARK(k); } while (0)

    constexpr int I_POOL = 4 * 32, I_UP = (D / 64) * (FF2 / 32), I_DOWN = (FF / 64) * (D / 32), I_Q = (D / 64) * (D / 32), I_KV = (D / 64) * (2 * D / 32), I_O = I_Q;
    if (IN(0)) {
        LAS float* scr = (LAS float*)(lds + wave * 16384);
        const int NWK = NGW;
        for (int r0 = gw * 4; r0 < M + 16; r0 += NWK * 4) {
            f32x4 v[4][4];
#pragma unroll
            for (int q = 0; q < 4; ++q) { const int r = r0 + q; const float* src = (r < M) ? x + (size_t)r * D : meta + (size_t)(r - M) * D;
#pragma unroll
                for (int j = 0; j < 4; ++j) v[q][j] = *(const f32x4*)(src + 4 * lane + 256 * j); }
#pragma unroll
            for (int q = 0; q < 4; ++q) { float sacc = 0.f;
#pragma unroll
                for (int j = 0; j < 4; ++j) sacc += (v[q][j][0] * v[q][j][0] + v[q][j][1] * v[q][j][1]) + (v[q][j][2] * v[q][j][2] + v[q][j][3] * v[q][j][3]);
                sacc = wave_sum(sacc); if (lane == 0) ssq0[r0 + q] = sacc; }
        }
        for (int it = gw; it < I_POOL + I_UP; it += NWK) {
            if (it < I_POOL) { const int g = it / 32; p0_transpose_item(pool_w + (size_t)g * 65536, 256, 256, Wpool_t, 256 * g, nullptr, scr, it % 32, lane); }
            else { const int itm = it - I_POOL, n0 = 32 * (itm % (FF2 / 32)); p0_transpose_item(w_up, D, FF2, Wup_t, upperm(n0) - n0, ffn_norm, scr, itm, lane); }
        }
        for (int i = bx * NTHREADS + tid; i < 4 * MR; i += G * NTHREADS) SSQ[i] = 0.f;
    }
    SEAM(0);
    if (IN(1)) {
        for (int it = bx; it < 4 * (M / 64); it += G) { const int rb = it % (M / 64), j = it / (M / 64); diff_block<false>(x, meta, mix_norm, ssq0, DIFF, rb / (T / 64), (rb % (T / 64)) * 64, j, (LAS float*)lds, tid); }
        for (int j = G - 1 - bx; j < 4; j += G) diff_block<true>(x, meta, mix_norm, ssq0, DIFF, 0, -16, j, (LAS float*)lds, tid);
    }
    SEAM(1);
    if (IN(2)) {
        pg8::Gemm g{DIFF, Wpool_t, M, D, 256, D, 256, 0}; pg8::StaticOrder S; S.init(M, D, G, bx);
        pg8::EpiRes E{x, nullptr, nullptr, HB, ssq1, pool_scale, D};
        pg8::gemm_phase<pg8::EpiRes, pg8::StaticOrder, false, true>(lds, g, S, E);
        for (int it = G - 1 - bx; it < D / 16; it += G) { const int n0 = it * 16, gsel = n0 / 256;
            thin_item(DIFF + (size_t)MROW * D + 256 * gsel, D, Wpool_t, 256, n0, lane, wave, (LAS float*)lds, [&](int row4, int col, const f32x4 acc) { thin_res_epi(meta, HM, HB, ssq1, pool_scale, row4, col, acc); }); }
    }
    SEAM(2);
    auto deferred_weights = [&]() {
        LAS float* scr = (LAS float*)(lds + wave * 16384);
        const int nlow = G, idx = bx;
        constexpr int NDEF = I_UP + 2 * I_DOWN + I_Q + I_KV + I_O;
        for (int it = idx * NWAVES + wave; it < NDEF; it += nlow * NWAVES) {
            int r = it;
            if (r < I_UP) { const int n0 = 32 * (r % (FF2 / 32)); p0_transpose_item(w_up + (size_t)D * FF2, D, FF2, Wup_t + (size_t)FF2 * D, upperm(n0) - n0, ffn_norm + D, scr, r, lane); continue; } r -= I_UP;
            if (r < 2 * I_DOWN) { const int l2 = r / I_DOWN; p0_transpose_item(w_down + (size_t)l2 * FF * D, FF, D, Wdown_t + (size_t)l2 * D * FF, 0, nullptr, scr, r % I_DOWN, lane); continue; } r -= 2 * I_DOWN;
            if (r < I_Q) { p0_transpose_item(w_q, D, D, Wqkv_t, 0, mix_norm + D, scr, r, lane); continue; } r -= I_Q;
            if (r < I_KV) { p0_transpose_item(w_kv, D, 2 * D, Wqkv_t, D, kv_norm, scr, r, lane); continue; } r -= I_KV;
            p0_transpose_item(w_o, D, D, Wo_t, 0, nullptr, scr, r, lane);
        }
    };
#define FFN_PHASES(l, pb, ssq_in, ssq_out) do { \
          \
        if (IN(pb)) { \
            const bf16* Wt = Wup_t + (size_t)(l) * FF2 * D; const float* cw_ = conv_w + (size_t)(l) * 3 * FF2; const float* cb_ = conv_b + (size_t)(l) * FF2; \
            pg8::Gemm g{HB, Wt, 68 * 256, FF2, D, D, 0, 2}; pg8::StaticOrder S; S.init(68 * 256, FF2, G, bx); \
            pg8::EpiConvGate E{U, ssq_in, cw_, cb_}; \
            pg8::gemm_phase<pg8::EpiConvGate, pg8::StaticOrder, true, true>(lds, g, S, E); \
            { const int rem_ = (68 * 22) % G, nlow_ = rem_ ? G - rem_ : G, idx_ = rem_ ? bx - rem_ : bx;        \
              if (idx_ >= 0) for (int it = idx_; it < FF / 16; it += nlow_) thin_up_convgate(HB, Wt, ssq_in, cw_, cb_, GM, it, lane, wave, (LAS float*)lds); } \
            if ((l) == 0) deferred_weights(); \
        } \
        SEAM(pb); \
          \
        if (IN(pb + 1)) { \
            const bf16* Wt = Wdown_t + (size_t)(l) * D * FF; \
            pg8::Gemm g{U, Wt, M, D, FF, FF, 0, 0}; pg8::StaticOrder S; S.init(M, D, G, bx); \
            pg8::EpiRes E{nullptr, HB, nullptr, HB, ssq_out, nullptr, D}; \
            pg8::gemm_phase<pg8::EpiRes, pg8::StaticOrder, false, true>(lds, g, S, E); \
            if ((l) == 0) \
                for (int it = G - 1 - bx; it < D / 16; it += G) \
                    thin_item(GM, FF, Wt, FF, it * 16, lane, wave, (LAS float*)lds, [&](int row4, int col, const f32x4 acc) { thin_res_epi(HM, HM, HB, ssq_out, nullptr, row4, col, acc); }); \
        } \
        SEAM(pb + 1); } while (0)
    FFN_PHASES(0, 3, ssq1, ssq2);
    if (IN(5)) {
        pg8::Gemm g{HB, Wqkv_t, M, 3 * D, D, D, 0, 1}; pg8::StaticOrder S; S.init(M, 3 * D, G, bx);
        pg8::EpiRsBf16 E{QB, D, ssq2, D, ACT_BYTES / 2, C2, nullptr};
        pg8::gemm_phase<pg8::EpiRsBf16, pg8::StaticOrder, true, true>(lds, g, S, E);
        for (int it = G - 1 - bx; it < 3 * D / 16; it += G)
            thin_item(HB, D, Wqkv_t, D, it * 16, lane, wave, (LAS float*)lds, [&](int row4, int col, const f32x4 acc) {
                const int tsel = col / D, cc = col % D; bf16* dst = QB + (size_t)tsel * (ACT_BYTES / 2);
#pragma unroll
                for (int i = 0; i < 4; ++i) { const int r = row4 + i; const float v = acc[i] * rs_of(ssq2[MROW + r]) * (tsel == 0 ? C2 : 1.f); dst[(size_t)(MROW + r) * D + cc] = (bf16)(pk2(v, 0.f) & 0xffffu); } });
        for (int i = bx * NTHREADS + tid; i < 2 * 48 * D / 8; i += G * NTHREADS) { const int which = i / (48 * D / 8), off = i % (48 * D / 8);
            *(v4u*)((which ? VB : KB) + (size_t)(MROW + 16) * D + (size_t)off * 8) = (v4u){0u, 0u, 0u, 0u}; }
    }
    SEAM(5);
    if (IN(6)) {
#if ATTN_SIMPLE
        attn_simple(QB, KB, VB, OB, 0, G, bx, tid);
#else
        sba::phase(lds, QB, KB, VB, OB, G, bx);
#endif
    }
    SEAM(6);
    if (IN(7)) {
        pg8::Gemm g{OB, Wo_t, M, D, D, D, 0, 0}; pg8::StaticOrder S; S.init(M, D, G, bx);
        pg8::EpiRes E{nullptr, HB, nullptr, HB, ssq3, nullptr, D};
        pg8::gemm_phase<pg8::EpiRes, pg8::StaticOrder, false, true>(lds, g, S, E);
        for (int it = G - 1 - bx; it < D / 16; it += G)
            thin_item(OB + (size_t)MROW * D, D, Wo_t, D, it * 16, lane, wave, (LAS float*)lds, [&](int row4, int col, const f32x4 acc) { thin_res_epi(HM, HM, HB, ssq3, nullptr, row4, col, acc); });
    }
    SEAM(7);
    FFN_PHASES(1, 8, ssq3, ssq4);
#undef FFN_PHASES
    if (IN(10)) {
        f32x4 gv[4];
#pragma unroll
        for (int j = 0; j < 4; ++j) gv[j] = *(const f32x4*)(final_norm + 4 * lane + 256 * j);
        for (int r0 = gw * 4; r0 < M; r0 += NGW * 4) {
            v2u w[4][4]; float rs[4];
#pragma unroll
            for (int q = 0; q < 4; ++q) { const bf16* hp = HB + (size_t)pg8::hbrow(r0 + q) * D + 4 * lane; rs[q] = rs_of(ssq4[r0 + q]);
#pragma unroll
                for (int j = 0; j < 4; ++j) w[q][j] = __builtin_nontemporal_load((const v2u*)(hp + 256 * j)); }
#pragma unroll
            for (int q = 0; q < 4; ++q) { float* p = out + (size_t)(r0 + q) * D + 4 * lane;
#pragma unroll
                for (int j = 0; j < 4; ++j) { const f32x4 v = {bflo(w[q][j].x), bfhi(w[q][j].x), bflo(w[q][j].y), bfhi(w[q][j].y)}; __builtin_nontemporal_store(v * rs[q] * gv[j], (f32x4*)(p + 256 * j)); } }
        }
    }
    PROBE_MARK(10);
#if PROBE_A >= 0
    if (bx == 0 && tid == 0) { const unsigned long long qa = (dA + 500) / 1000, qb = (dB + 500) / 1000;
        const unsigned long long spin = (PROBE_B >= 0) ? qa * 100000ull + qb * 5000ull : dA * 10ull; const unsigned long long t0 = __builtin_amdgcn_s_memrealtime();
        while (__builtin_amdgcn_s_memrealtime() - t0 < spin) __builtin_amdgcn_s_sleep(32); }
#endif
#undef IN
#undef SEAM
}

extern "C" void kernel_launch(void* const* d_in, const int* in_sizes, int n_in, void* d_out, int out_size, void* d_ws, size_t ws_size, hipStream_t stream) {
    static int grid = 0;
    if (grid == 0) {
        if (n_in != 15 || in_sizes[0] != M * D || out_size != M * D || ws_size < WS_END) { fprintf(stderr, "kernel_launch: unexpected shapes (n_in %d, in0 %d, out %d, ws %zu, need %zu); nothing launched\n", n_in, n_in > 0 ? in_sizes[0] : -1, out_size, ws_size, (size_t)WS_END); grid = -1; return; }
        int dev = 0, cus = 0, per_cu = 0;
        if (hipGetDevice(&dev) != hipSuccess || hipDeviceGetAttribute(&cus, hipDeviceAttributeMultiprocessorCount, dev) != hipSuccess) { grid = -1; return; }
        if (hipFuncSetAttribute((const void*)yoco_fwd, hipFuncAttributeMaxDynamicSharedMemorySize, LDS_BYTES) != hipSuccess) { fprintf(stderr, "kernel_launch: hipFuncSetAttribute failed\n"); grid = -1; return; }
        if (hipOccupancyMaxActiveBlocksPerMultiprocessor(&per_cu, (const void*)yoco_fwd, NTHREADS, LDS_BYTES) != hipSuccess || per_cu < 1) per_cu = 1;
        (void)hipGetLastError();
        grid = cus * per_cu;
    }
    if (grid < 0) return;
    if (hipMemsetAsync((char*)d_ws + WS_CTL, 0, CTL_BYTES, stream) != hipSuccess) { fprintf(stderr, "kernel_launch: hipMemsetAsync failed\n"); return; }
    Args a{};
    for (int i = 0; i < 15; ++i) a.in[i] = (const float*)d_in[i];
    a.out = (float*)d_out; a.ws = (unsigned char*)d_ws;
#if MK_N_LAUNCHES == 1
    a.ph_lo = 0; a.ph_hi = NPHASES;
    void* kargs[] = {&a};
    hipError_t e = hipLaunchCooperativeKernel((const void*)yoco_fwd, dim3(grid), dim3(NTHREADS), kargs, LDS_BYTES, stream);
    if (e != hipSuccess) fprintf(stderr, "kernel_launch: cooperative launch failed: %s (grid %d)\n", hipGetErrorString(e), grid);
#else
    for (int p = 0; p < NPHASES; ++p) { a.ph_lo = p; a.ph_hi = p + 1; hipLaunchKernelGGL(yoco_fwd, dim3(grid), dim3(NTHREADS), LDS_BYTES, stream, a); }
#endif
}
```

```cpp
#include <hip/hip_runtime.h>
#include <hip/hip_cooperative_groups.h>
#include <cstdio>
#include <cstdint>
namespace cg = cooperative_groups;
namespace pg8 {
#define PG8_LAS __attribute__((address_space(3)))
typedef unsigned short bf16_t;
typedef short bf16x8 __attribute__((ext_vector_type(8)));
typedef float f32x4 __attribute__((ext_vector_type(4)));
typedef unsigned u32x4 __attribute__((ext_vector_type(4)));
constexpr int BM = 256, BK = 64, HALF = 128, HTB = HALF * BK * 2  , STAGE_BYTES = 8 * HTB, NXCD = 8, WGM = 8;

__host__ __device__ __forceinline__ int lds_byte(int r, int c) { const int st = (r >> 4) * 2 + (c >> 5), rr = r & 15, cc = c & 31, ob = rr * 64 + cc * 2; return st * 1024 + (ob ^ (((ob >> 9) & 1) << 5)); }
__host__ __device__ __forceinline__ void stage_rc(int b, int& R, int& C) { const int st = b / 1024, sb = b % 1024, swz = sb ^ (((sb >> 9) & 1) << 5); R = (st >> 1) * 16 + swz / 64; C = (st & 1) * 32 + (swz % 64) / 2; }
__host__ __device__ __forceinline__ int perm32(int rho) { const int n = rho >> 4, i = rho & 15; return 8 * (i >> 2) + 4 * n + (i & 3); }

struct Unit { int pm, pn; };
struct Gemm { const bf16_t* A; const bf16_t* Bt; int M, N, K, lda, acs, amode; };
__host__ __device__ __forceinline__ int hbrow(int r) { return r + 16 * ((r >> 12) + 1); }

struct StaticOrder {
    int nM, nN, nwg, G, c;
    __host__ __device__ void init(int M, int N, int G_, int c_) { nM = M / BM; nN = N / BM; nwg = nM * nN; G = G_; c = c_; }
    __host__ __device__ bool next(int i, Unit& u) const {
        const long L = (long)i * G + c; if (L >= nwg) return false;
        int wgid = (int)L; { const int q = nwg / NXCD, r = nwg % NXCD, xcd = wgid % NXCD, off = wgid / NXCD; wgid = (xcd < r ? xcd * (q + 1) : r * (q + 1) + (xcd - r) * q) + off; }
        const int nig = WGM * nN, gid = wgid / nig, fm = gid * WGM, gsz = (nM - fm) < WGM ? (nM - fm) : WGM;
        u.pm = fm + ((wgid % nig) % gsz); u.pn = (wgid % nig) / gsz; return true;
    }
    __device__ __forceinline__ void a_ready(const Unit&) const {}
    __device__ __forceinline__ void done(const Unit&) const {}
};

__device__ __forceinline__ unsigned cvt_pk_bf16(float lo, float hi) { unsigned r; asm volatile("v_cvt_pk_bf16_f32 %0, %1, %2" : "=v"(r) : "v"(lo), "v"(hi)); return r; }
typedef unsigned u32x2 __attribute__((ext_vector_type(2)));
constexpr float RMS_EPS_C = 1e-6f;
struct EpiRsBf16 {
    static constexpr bool PERM = true, AFTER_DRAIN = false;
    bf16_t* O; int ldc; const float* ssq; int split_cols; size_t split_stride; float scale0; bf16_t* halo;
    __device__ __forceinline__ void operator()(const f32x4 (&acc)[2][2][4][2], const Unit& u, int wr, int wc, int fr, int fq) const {
        const int row0 = u.pm * BM + wr * 64 + fr; int colt = u.pn * BM; bf16_t* base = O;
        float sc = 1.f; if (split_cols) { const int t = colt / split_cols; base += (size_t)t * split_stride; colt -= t * split_cols; if (t == 0) sc = scale0; }
        const int col0 = colt + wc * 32 + 8 * fq;
#pragma unroll
        for (int ai = 0; ai < 2; ++ai)
#pragma unroll
            for (int m = 0; m < 4; ++m) { const int row = row0 + ai * HALF + m * 16; const float rs = __builtin_amdgcn_rsqf(ssq[row] * (1.0f / 1024.0f) + RMS_EPS_C) * sc;
                bf16_t* rowp = base + (size_t)row * ldc + col0;
#pragma unroll
                for (int bj = 0; bj < 2; ++bj) { const f32x4 v0 = acc[ai][bj][m][0] * rs, v1 = acc[ai][bj][m][1] * rs;
                    u32x4 w; w.x = cvt_pk_bf16(v0[0], v0[1]); w.y = cvt_pk_bf16(v0[2], v0[3]); w.z = cvt_pk_bf16(v1[0], v1[1]); w.w = cvt_pk_bf16(v1[2], v1[3]);
                    *(u32x4*)(rowp + bj * HALF) = w;
                    if (halo != nullptr && ai == 1 && m == 3 && wr == 1 && fr >= 14) *(u32x4*)(halo + (size_t)(u.pm * 2 + (fr - 14)) * ldc + col0 + bj * HALF) = w; } }
    }
};
struct EpiRes {
    static constexpr bool PERM = true, AFTER_DRAIN = false;
    const float* base; const bf16_t* baseb; float* out; bf16_t* hb; float* ssq; const float* cscale; int ldc;
    __device__ __forceinline__ void operator()(const f32x4 (&acc)[2][2][4][2], const Unit& u, int wr, int wc, int fr, int fq) const {
        const int col0 = u.pn * BM + wc * 32 + 8 * fq;
        f32x4 cs[2][2];
#pragma unroll
        for (int bj = 0; bj < 2; ++bj)
#pragma unroll
            for (int n = 0; n < 2; ++n) cs[bj][n] = cscale ? *(const f32x4*)(cscale + col0 + bj * HALF + n * 4) : (f32x4){1.f, 1.f, 1.f, 1.f};
#pragma unroll
        for (int ai = 0; ai < 2; ++ai) {
            u32x4 wb[4][2]; f32x4 fb[4][2][2];
#pragma unroll
            for (int m = 0; m < 4; ++m) { const int r_ = u.pm * BM + ai * HALF + wr * 64 + m * 16 + fr; const size_t off = (size_t)r_ * ldc + col0, offh = (size_t)hbrow(r_) * ldc + col0;
#pragma unroll
                for (int bj = 0; bj < 2; ++bj) { if (baseb != nullptr) wb[m][bj] = *(const u32x4*)(baseb + offh + bj * HALF);
                    else { fb[m][bj][0] = __builtin_nontemporal_load((const f32x4*)(base + off + bj * HALF)); fb[m][bj][1] = __builtin_nontemporal_load((const f32x4*)(base + off + bj * HALF + 4)); } } }
#pragma unroll
            for (int m = 0; m < 4; ++m) { const int r = u.pm * BM + ai * HALF + wr * 64 + m * 16 + fr; const size_t off = (size_t)r * ldc + col0, offh = (size_t)hbrow(r) * ldc + col0; float q = 0.f;
#pragma unroll
                for (int bj = 0; bj < 2; ++bj) { f32x4 b0, b1;
                    if (baseb != nullptr) { const u32x4 w = wb[m][bj];
                        b0 = (f32x4){__uint_as_float(w.x << 16), __uint_as_float(w.x & 0xffff0000u), __uint_as_float(w.y << 16), __uint_as_float(w.y & 0xffff0000u)};
                        b1 = (f32x4){__uint_as_float(w.z << 16), __uint_as_float(w.z & 0xffff0000u), __uint_as_float(w.w << 16), __uint_as_float(w.w & 0xffff0000u)}; }
                    else { b0 = fb[m][bj][0]; b1 = fb[m][bj][1]; }
                    const f32x4 o0 = b0 + acc[ai][bj][m][0] * cs[bj][0], o1 = b1 + acc[ai][bj][m][1] * cs[bj][1];
                    if (out != nullptr) { *(f32x4*)(out + off + bj * HALF) = o0; *(f32x4*)(out + off + bj * HALF + 4) = o1; }
                    q += ((o0[0] * o0[0] + o0[1] * o0[1]) + (o0[2] * o0[2] + o0[3] * o0[3])) + ((o1[0] * o1[0] + o1[1] * o1[1]) + (o1[2] * o1[2] + o1[3] * o1[3]));
                    if (hb != nullptr) { u32x4 w; w.x = cvt_pk_bf16(o0[0], o0[1]); w.y = cvt_pk_bf16(o0[2], o0[3]); w.z = cvt_pk_bf16(o1[0], o1[1]); w.w = cvt_pk_bf16(o1[2], o1[3]); *(u32x4*)(hb + offh + bj * HALF) = w; } }
                q += __shfl_xor(q, 16); q += __shfl_xor(q, 32);
                if (fq == 0) atomicAdd(ssq + r, q); }
            asm volatile("" ::: "memory");
        }
    }
};

struct EpiConvGate {
    static constexpr bool PERM = true, AFTER_DRAIN = false;
    bf16_t* G; const float* ssq; const float* cw; const float* cb;
    template <int N, bool HASPREV> static __device__ __forceinline__ float rowm(float cur, float prev) {
        const int top = HASPREV ? __builtin_amdgcn_update_dpp(0, __builtin_bit_cast(int, prev), N == 1 ? 0x10f : 0x10e, 0xf, 0xf, true) : 0;
        return __builtin_bit_cast(float, __builtin_amdgcn_update_dpp(top, __builtin_bit_cast(int, cur), N == 1 ? 0x111 : 0x112, 0xf, 0xf, false));
    }
    __device__ __forceinline__ void operator()(const f32x4 (&acc)[2][2][4][2], const Unit& u, int wr, int wc, int fr, int fq) const {
        const int batch = u.pm / 17, ti = u.pm % 17, j0 = 128 * u.pn + 32 * wc + 8 * fq;
        float rs[2][4]; unsigned pk[2][4][4];
#pragma unroll
        for (int ai = 0; ai < 2; ++ai)
#pragma unroll
            for (int m = 0; m < 4; ++m) { const int t = 248 * ti - 2 + 62 * (2 * ai + wr) + fr + 16 * m; const int si = (t >= 0) ? batch * 4096 + t : 16384 + 16 + t; rs[ai][m] = __builtin_amdgcn_rsqf(ssq[si] * (1.0f / 1024.0f) + RMS_EPS_C); }
#pragma unroll
        for (int n = 0; n < 2; ++n)
#pragma unroll
            for (int ep = 0; ep < 2; ++ep) {
                float o[2][2][4];
#pragma unroll
                for (int c = 0; c < 2; ++c) { const int e = 2 * ep + c, ch = j0 + 4 * n + e;
                    const float wg0 = cw[ch], wg1 = cw[5632 + ch], wg2 = cw[2 * 5632 + ch], bg = cb[ch];
                    const float wv0 = cw[2816 + ch], wv1 = cw[5632 + 2816 + ch], wv2 = cw[2 * 5632 + 2816 + ch], bv = cb[2816 + ch];
#pragma unroll
                    for (int ai = 0; ai < 2; ++ai) {
                        float ug[4], uv[4];
#pragma unroll
                        for (int m = 0; m < 4; ++m) { ug[m] = acc[ai][0][m][n][e] * rs[ai][m]; uv[m] = acc[ai][1][m][n][e] * rs[ai][m]; }
#pragma unroll
                        for (int m = 0; m < 4; ++m) {
                            const float p1g = (m > 0) ? rowm<1, true>(ug[m], ug[m > 0 ? m - 1 : 0]) : rowm<1, false>(ug[m], 0.f), p2g = (m > 0) ? rowm<2, true>(ug[m], ug[m > 0 ? m - 1 : 0]) : rowm<2, false>(ug[m], 0.f);
                            const float p1v = (m > 0) ? rowm<1, true>(uv[m], uv[m > 0 ? m - 1 : 0]) : rowm<1, false>(uv[m], 0.f), p2v = (m > 0) ? rowm<2, true>(uv[m], uv[m > 0 ? m - 1 : 0]) : rowm<2, false>(uv[m], 0.f);
                            const float gc = __builtin_fmaf(wg0, p2g, __builtin_fmaf(wg1, p1g, __builtin_fmaf(wg2, ug[m], bg)));
                            const float vc = __builtin_fmaf(wv0, p2v, __builtin_fmaf(wv1, p1v, __builtin_fmaf(wv2, uv[m], bv)));
                            o[ai][c][m] = gc * __builtin_amdgcn_rcpf(1.0f + __builtin_amdgcn_exp2f(-1.4426950408889634f * gc)) * vc;
                        }
                    }
                }
#pragma unroll
                for (int ai = 0; ai < 2; ++ai)
#pragma unroll
                    for (int m = 0; m < 4; ++m) pk[ai][m][2 * n + ep] = cvt_pk_bf16(o[ai][0][m], o[ai][1][m]);
            }
#pragma unroll
        for (int ai = 0; ai < 2; ++ai)
#pragma unroll
            for (int m = 0; m < 4; ++m) { const int l = 16 * m + fr, t = 248 * ti - 2 + 62 * (2 * ai + wr) + l;
                if (l >= 2 && t < 4096) { u32x4 w; w.x = pk[ai][m][0]; w.y = pk[ai][m][1]; w.z = pk[ai][m][2]; w.w = pk[ai][m][3]; *(u32x4*)(G + (size_t)(batch * 4096 + t) * 2816 + j0) = w; } }
    }
};

template <class Epi, class Sched, bool ALIGN_EPI = false, bool SP2 = false>
__device__ __forceinline__ void gemm_phase(PG8_LAS unsigned char* lds, const Gemm g, const Sched& S, const Epi& E) {
    const int tid = threadIdx.x, wid = __builtin_amdgcn_readfirstlane(tid >> 6), lane = tid & 63, wr = wid >> 2, wc = wid & 3, fr = lane & 15, fq = lane >> 4;
    const int K = g.K, nt = K / BK;
    unsigned voffA[2], voffB[2];
#pragma unroll
    for (int i = 0; i < 2; ++i) { int R, C; stage_rc(tid * 16 + i * 8192, R, C); const int Rb = Epi::PERM ? ((R & ~31) + perm32(R & 31)) : R;
        voffA[i] = (unsigned)((g.amode == 2 ? R - 2 * (R >> 6) : R) * g.lda + C) * 2u; voffB[i] = (unsigned)(Rb * K + C) * 2u; }
    const size_t kstep = (size_t)(BK * 2);
    const size_t hstepA = (size_t)(g.amode == 2 ? 124 : HALF) * g.lda * 2, hstepB = (size_t)HALF * K * 2;
    const size_t tstepB = 2 * hstepB; const size_t acsb = (size_t)g.acs * 2; const size_t rowb = (size_t)g.lda * 2;
#define PG8_AROW(pm) ((size_t)(g.amode == 0 ? (pm) * 256 : g.amode == 1 ? (pm) * 256 + 16 * (((pm) >> 4) + 1) : ((pm) / 17) * 4112 + 14 + 248 * ((pm) % 17)))
    const unsigned ldsw = (unsigned)wid * 1024u;
    const int aoff = lds_byte(wr * 64 + fr, fq * 8), boff = lds_byte(wc * 32 + fr, fq * 8);
#define PG8_SA(b, h) (((b) * 2 + (h)) * HTB)
#define PG8_SB(b, h) ((4 + (b) * 2 + (h)) * HTB)
#define PG8_STAGE(bufoff, gbase, voff) do { _Pragma("unroll") for (int _i = 0; _i < 2; ++_i) \
        __builtin_amdgcn_global_load_lds((const unsigned*)((const char*)(gbase) + (voff)[_i]), (PG8_LAS unsigned*)(lds + (bufoff) + ldsw + _i * 8192), 16, 0, 0); } while (0)
#define PG8_LDA(dst, b, h) do { _Pragma("unroll") for (int m = 0; m < 4; ++m) _Pragma("unroll") for (int k = 0; k < 2; ++k) dst[m][k] = *(const PG8_LAS bf16x8*)(lds + PG8_SA(b, h) + aoff + m * 2048 + k * 1024); } while (0)
#define PG8_LDB(dst, b, h) do { _Pragma("unroll") for (int n = 0; n < 2; ++n) _Pragma("unroll") for (int k = 0; k < 2; ++k) dst[n][k] = *(const PG8_LAS bf16x8*)(lds + PG8_SB(b, h) + boff + n * 2048 + k * 1024); } while (0)
#define PG8_MMA(ai, bj, At, Bt) do { __builtin_amdgcn_s_setprio(1); _Pragma("unroll") for (int m = 0; m < 4; ++m) _Pragma("unroll") for (int n = 0; n < 2; ++n) _Pragma("unroll") for (int k = 0; k < 2; ++k) \
        acc[ai][bj][m][n] = __builtin_amdgcn_mfma_f32_16x16x32_bf16(Bt[n][k], At[m][k], acc[ai][bj][m][n], 0, 0, 0); __builtin_amdgcn_s_setprio(0); } while (0)
#define PG8_WAIT_V(n) asm volatile("s_waitcnt vmcnt(" #n ")" ::: "memory")
#define PG8_WAIT_L(n) asm volatile("s_waitcnt lgkmcnt(" #n ")" ::: "memory")
#define PG8_BAR __builtin_amdgcn_s_barrier()
#define PG8_SCHED __builtin_amdgcn_sched_barrier(0)
    Unit cur, nxt; int ui = 0;
    if (!S.next(0, cur)) return;
    f32x4 acc[2][2][4][2];
#pragma unroll
    for (int a = 0; a < 2; ++a)
#pragma unroll
        for (int b = 0; b < 2; ++b)
#pragma unroll
            for (int m = 0; m < 4; ++m)
#pragma unroll
                for (int n = 0; n < 2; ++n) acc[a][b][m][n] = (f32x4){0.f, 0.f, 0.f, 0.f};
    bf16x8 At[4][2], B0[2][2], B1[2][2];
    const char* cA = (const char*)g.A + PG8_AROW(cur.pm) * rowb + (size_t)cur.pn * acsb; const char* cB = (const char*)g.Bt + (size_t)cur.pn * tstepB;
    S.a_ready(cur);
    if constexpr (SP2) {
        PG8_STAGE(PG8_SB(0, 0), cB, voffB); PG8_STAGE(PG8_SB(0, 1), cB + hstepB, voffB); PG8_STAGE(PG8_SA(0, 0), cA, voffA); PG8_STAGE(PG8_SA(0, 1), cA + hstepA, voffA);
        if (wr == 1) PG8_BAR;
        PG8_WAIT_V(2); PG8_BAR;
        PG8_STAGE(PG8_SB(1, 0), cB + kstep, voffB); PG8_STAGE(PG8_SA(1, 0), cA + kstep, voffA); PG8_STAGE(PG8_SB(1, 1), cB + hstepB + kstep, voffB);
        PG8_WAIT_V(6); PG8_BAR;
    } else {
        PG8_STAGE(PG8_SB(0, 0), cB, voffB); PG8_STAGE(PG8_SA(0, 0), cA, voffA); PG8_STAGE(PG8_SB(0, 1), cB + hstepB, voffB); PG8_STAGE(PG8_SA(0, 1), cA + hstepA, voffA);
        if (wr == 1) PG8_BAR;
        PG8_WAIT_V(4); PG8_BAR;
        PG8_STAGE(PG8_SB(1, 0), cB + kstep, voffB); PG8_STAGE(PG8_SA(1, 0), cA + kstep, voffA); PG8_STAGE(PG8_SB(1, 1), cB + hstepB + kstep, voffB);
        PG8_WAIT_V(6); PG8_BAR;
    }
    for (;;) {
        const bool has_next = S.next(ui + 1, nxt);
        const char* nA = has_next ? (const char*)g.A + PG8_AROW(nxt.pm) * rowb + (size_t)nxt.pn * acsb : cA; const char* nB = has_next ? (const char*)g.Bt + (size_t)nxt.pn * tstepB : cB;
        for (int t = 0; t < nt; t += 2) {
            const bool last = (t == nt - 2);
            const char* a1 = cA + (size_t)(t + 1) * kstep;
            const char* a2 = last ? nA : cA + (size_t)(t + 2) * kstep; const char* b2 = last ? nB : cB + (size_t)(t + 2) * kstep;
            const char* a3 = a2 + kstep; const char* b3 = b2 + kstep;
            if (last && has_next) S.a_ready(nxt);
            if constexpr (SP2) {
            PG8_LDB(B0, 0, 0); PG8_LDB(B1, 0, 1); PG8_SCHED; PG8_LDA(At, 0, 0); PG8_STAGE(PG8_SA(1, 1), a1 + hstepA, voffA);
            PG8_WAIT_V(8); PG8_WAIT_L(0); PG8_BAR; PG8_MMA(0, 0, At, B0); PG8_MMA(0, 1, At, B1); PG8_BAR; PG8_SCHED;
            PG8_LDA(At, 0, 1); PG8_STAGE(PG8_SB(0, 0), b2, voffB); PG8_STAGE(PG8_SB(0, 1), b2 + hstepB, voffB); PG8_STAGE(PG8_SA(0, 0), a2, voffA);
            PG8_WAIT_V(8); PG8_WAIT_L(0); PG8_BAR; PG8_MMA(1, 0, At, B0); PG8_MMA(1, 1, At, B1); PG8_BAR; PG8_SCHED;
            PG8_LDB(B0, 1, 0); PG8_LDB(B1, 1, 1); PG8_SCHED; PG8_LDA(At, 1, 0); PG8_STAGE(PG8_SA(0, 1), a2 + hstepA, voffA);
            PG8_WAIT_V(8); PG8_WAIT_L(0); PG8_BAR; PG8_MMA(0, 0, At, B0); PG8_MMA(0, 1, At, B1); PG8_BAR; PG8_SCHED;
            PG8_LDA(At, 1, 1); PG8_STAGE(PG8_SB(1, 0), b3, voffB); PG8_STAGE(PG8_SB(1, 1), b3 + hstepB, voffB); PG8_STAGE(PG8_SA(1, 0), a3, voffA);
            PG8_WAIT_V(8); PG8_WAIT_L(0); PG8_BAR; PG8_MMA(1, 0, At, B0); PG8_MMA(1, 1, At, B1); PG8_BAR; PG8_SCHED;
            } else {
            PG8_LDB(B0, 0, 0); PG8_SCHED; PG8_LDA(At, 0, 0); PG8_STAGE(PG8_SA(1, 1), a1 + hstepA, voffA);
            PG8_WAIT_L(8); PG8_BAR; PG8_WAIT_L(0); PG8_MMA(0, 0, At, B0); PG8_BAR; PG8_SCHED;
            PG8_LDB(B1, 0, 1); PG8_STAGE(PG8_SB(0, 0), b2, voffB);
            PG8_BAR; PG8_WAIT_L(0); PG8_MMA(0, 1, At, B1); PG8_BAR;
            PG8_LDA(At, 0, 1); PG8_STAGE(PG8_SA(0, 0), a2, voffA);
            PG8_BAR; PG8_WAIT_L(0); PG8_MMA(1, 0, At, B0); PG8_BAR; PG8_SCHED;
            PG8_STAGE(PG8_SB(0, 1), b2 + hstepB, voffB);
            PG8_WAIT_V(6); PG8_BAR; PG8_MMA(1, 1, At, B1); PG8_BAR;
            PG8_LDB(B0, 1, 0); PG8_SCHED; PG8_LDA(At, 1, 0); PG8_STAGE(PG8_SA(0, 1), a2 + hstepA, voffA);
            PG8_WAIT_L(8); PG8_BAR; PG8_WAIT_L(0); PG8_MMA(0, 0, At, B0); PG8_BAR; PG8_SCHED;
            PG8_LDB(B1, 1, 1); PG8_STAGE(PG8_SB(1, 0), b3, voffB);
            PG8_BAR; PG8_WAIT_L(0); PG8_MMA(0, 1, At, B1); PG8_BAR;
            PG8_LDA(At, 1, 1); PG8_STAGE(PG8_SA(1, 0), a3, voffA);
            PG8_BAR; PG8_WAIT_L(0); PG8_MMA(1, 0, At, B0); PG8_BAR; PG8_SCHED;
            PG8_STAGE(PG8_SB(1, 1), b3 + hstepB, voffB);
            PG8_WAIT_V(6); PG8_BAR; PG8_MMA(1, 1, At, B1); PG8_BAR;
            }
        }
        if constexpr (ALIGN_EPI) { if (wr == 0) PG8_BAR; }
        if constexpr (!Epi::AFTER_DRAIN) { E(acc, cur, wr, wc, fr, fq); S.done(cur); }
        if (!has_next) break;
#pragma unroll
        for (int a = 0; a < 2; ++a)
#pragma unroll
            for (int b = 0; b < 2; ++b)
#pragma unroll
                for (int m = 0; m < 4; ++m)
#pragma unroll
                    for (int n = 0; n < 2; ++n) acc[a][b][m][n] = (f32x4){0.f, 0.f, 0.f, 0.f};
        cur = nxt; cA = nA; cB = nB; ++ui;
        if constexpr (ALIGN_EPI) { if (wr == 1) PG8_BAR; }
    }
    PG8_WAIT_V(0);
    if constexpr (!ALIGN_EPI) { if (wr == 0) PG8_BAR; }
    PG8_BAR;
    if constexpr (Epi::AFTER_DRAIN) { E.fused(acc, cur, wr, wc, fr, fq, lds, wid, lane); S.done(cur); }
#undef PG8_AROW
#undef PG8_SA
#undef PG8_SB
#undef PG8_STAGE
#undef PG8_LDA
#undef PG8_LDB
#undef PG8_MMA
#undef PG8_WAIT_V
#undef PG8_WAIT_L
#undef PG8_BAR
#undef PG8_SCHED
}
}
namespace sba {
#define SBA_LAS __attribute__((address_space(3)))
typedef unsigned short bf16;
using bf16x8 = __attribute__((ext_vector_type(8))) short;
using s16x4 = __attribute__((ext_vector_type(4))) short;
using f32x16 = __attribute__((ext_vector_type(16))) float;
using u32x4 = __attribute__((ext_vector_type(4))) unsigned;
constexpr int AT = 4096, AD = 1024, AMROW = 16384;
constexpr int SLOTB = 8192, LDS_K = 0, LDS_V = 3 * SLOTB, LDS_OST = 6 * SLOTB;
__device__ __forceinline__ int crow(int r, int hi) { return (r & 3) + 8 * (r >> 2) + 4 * hi; }
__device__ __forceinline__ void glds16(const void* gsrc, unsigned lds_dst) { unsigned keep;
    asm volatile("s_mov_b32 %0, m0\n\ts_mov_b32 m0, %2\n\ts_nop 0\n\tglobal_load_lds_dwordx4 %1, off\n\ts_mov_b32 m0, %0" : "=&s"(keep) : "v"(gsrc), "s"(lds_dst) : "memory"); }
typedef float f32x2_t __attribute__((ext_vector_type(2))); typedef __bf16 bf16x2_t __attribute__((ext_vector_type(2)));
__device__ __forceinline__ unsigned cvtpk_s(float lo, float hi) { f32x2_t v = {lo, hi}; bf16x2_t b = __builtin_convertvector(v, bf16x2_t); return __builtin_bit_cast(unsigned, b); }
__device__ __forceinline__ float fmul_s(float a, float b) { float r = a * b; asm("" : "+v"(r)); return r; }
__device__ __forceinline__ float fsub_s(float a, float b) { float r = a - b; asm("" : "+v"(r)); return r; }
__device__ __forceinline__ float fadd_s(float a, float b) { float r = a + b; asm("" : "+v"(r)); return r; }
#define SBA_WAIT_BAR(N) asm volatile("s_waitcnt vmcnt(" #N ") lgkmcnt(0)\n\ts_barrier" ::: "memory")
__device__ __forceinline__ void pv(f32x16* o, int vb, bf16x8 pa0, bf16x8 pa1, bf16x8 pa2, bf16x8 pa3) {
#pragma unroll
    for (int d0 = 0; d0 < 2; ++d0) { s16x4 lo[4], hi[4];
#pragma unroll
        for (int ks = 0; ks < 4; ++ks) {
            asm volatile("ds_read_b64_tr_b16 %0,%1 offset:%c2" : "=&v"(lo[ks]) : "v"(vb), "i"(d0 * 4096 + ks * 1024) : "memory");
            asm volatile("ds_read_b64_tr_b16 %0,%1 offset:%c2" : "=&v"(hi[ks]) : "v"(vb), "i"(d0 * 4096 + ks * 1024 + 512) : "memory"); }
        asm volatile("s_waitcnt lgkmcnt(0)" ::: "memory"); __builtin_amdgcn_sched_barrier(0);
#define SBA_PK(k) (bf16x8){lo[k][0], lo[k][1], lo[k][2], lo[k][3], hi[k][0], hi[k][1], hi[k][2], hi[k][3]}
        o[d0] = __builtin_amdgcn_mfma_f32_32x32x16_bf16(pa0, SBA_PK(0), o[d0], 0, 0, 0);
        o[d0] = __builtin_amdgcn_mfma_f32_32x32x16_bf16(pa1, SBA_PK(1), o[d0], 0, 0, 0);
        o[d0] = __builtin_amdgcn_mfma_f32_32x32x16_bf16(pa2, SBA_PK(2), o[d0], 0, 0, 0);
        o[d0] = __builtin_amdgcn_mfma_f32_32x32x16_bf16(pa3, SBA_PK(3), o[d0], 0, 0, 0);
#undef SBA_PK
    }
}
template <bool MASK>
__device__ __forceinline__ void tile(f32x16 (&o)[2], float& R, const bf16x8 (&qr)[4], SBA_LAS const unsigned char* kslot, int vb, int r32, int hi, int lim) {
    SBA_LAS const unsigned char* kb = kslot + hi * 1024 + r32 * 16;
    f32x16 p0 = {}, p1 = {};
#pragma unroll
    for (int d0 = 0; d0 < 4; ++d0) {
        const bf16x8 b0 = *(SBA_LAS const bf16x8*)(kb + d0 * 2048);
        const bf16x8 b1 = *(SBA_LAS const bf16x8*)(kb + d0 * 2048 + 512);
        p0 = __builtin_amdgcn_mfma_f32_32x32x16_bf16(b0, qr[d0], p0, 0, 0, 0);
        p1 = __builtin_amdgcn_mfma_f32_32x32x16_bf16(b1, qr[d0], p1, 0, 0, 0);
    }
    const int limh = lim - 4 * hi;
#pragma unroll
    for (int r = 0; r < 16; ++r) {
        float a0 = __builtin_amdgcn_rcpf(fadd_s(__builtin_amdgcn_exp2f(p0[r]), 1.0f)), a1 = __builtin_amdgcn_rcpf(fadd_s(__builtin_amdgcn_exp2f(p1[r]), 1.0f));
        if (MASK) { const int kv = (r & 3) + 8 * (r >> 2); a0 = (kv < limh) ? a0 : 1.0f; a1 = (kv + 32 < limh) ? a1 : 1.0f; }
        p0[r] = a0; p1[r] = a1;
    }
    float tl[8], th[8];
#pragma unroll
    for (int I = 0; I < 8; ++I) {
        const float t = (I < 4) ? fmul_s(fmul_s(p0[4 * I], p0[4 * I + 1]), fmul_s(p0[4 * I + 2], p0[4 * I + 3])) : fmul_s(fmul_s(p1[4 * I - 16], p1[4 * I - 15]), fmul_s(p1[4 * I - 14], p1[4 * I - 13]));
        auto rr = __builtin_amdgcn_permlane32_swap(__float_as_uint(t), __float_as_uint(t), false, false);
        tl[I] = __uint_as_float(rr[0]); th[I] = __uint_as_float(rr[1]);
    }
#pragma unroll
    for (int I = 7; I >= 0; --I) {
        float E = fmul_s(R, hi ? 1.0f : th[I]);
        if (I < 4) {
#pragma unroll
            for (int c = 3; c >= 0; --c) { const float P = fmul_s(E, p0[4 * I + c]); p0[4 * I + c] = fsub_s(E, P); E = P; }
        } else {
#pragma unroll
            for (int c = 3; c >= 0; --c) { const float P = fmul_s(E, p1[4 * I - 16 + c]); p1[4 * I - 16 + c] = fsub_s(E, P); E = P; }
        }
        R = fmul_s(R, fmul_s(tl[I], th[I]));
    }
    u32x4 pw0, pw1, pw2, pw3;
    pw0 = (u32x4){cvtpk_s(p0[0], p0[1]), cvtpk_s(p0[2], p0[3]), cvtpk_s(p0[4], p0[5]), cvtpk_s(p0[6], p0[7])};
    pw1 = (u32x4){cvtpk_s(p0[8], p0[9]), cvtpk_s(p0[10], p0[11]), cvtpk_s(p0[12], p0[13]), cvtpk_s(p0[14], p0[15])};
    pw2 = (u32x4){cvtpk_s(p1[0], p1[1]), cvtpk_s(p1[2], p1[3]), cvtpk_s(p1[4], p1[5]), cvtpk_s(p1[6], p1[7])};
    pw3 = (u32x4){cvtpk_s(p1[8], p1[9]), cvtpk_s(p1[10], p1[11]), cvtpk_s(p1[12], p1[13]), cvtpk_s(p1[14], p1[15])};
    __builtin_amdgcn_sched_barrier(0);
    pv(o, vb, __builtin_bit_cast(bf16x8, pw0), __builtin_bit_cast(bf16x8, pw1), __builtin_bit_cast(bf16x8, pw2), __builtin_bit_cast(bf16x8, pw3));
}
template <bool MASK>
__device__ __forceinline__ void tile32(f32x16 (&o)[2], float& R, const bf16x8 (&qr)[4], SBA_LAS const unsigned char* kimg, int vb, int r32, int hi, int lim) {
    SBA_LAS const unsigned char* kb = kimg + hi * 512 + r32 * 16;
    f32x16 p0 = {};
#pragma unroll
    for (int d0 = 0; d0 < 4; ++d0) { const bf16x8 b0 = *(SBA_LAS const bf16x8*)(kb + d0 * 1024); p0 = __builtin_amdgcn_mfma_f32_32x32x16_bf16(b0, qr[d0], p0, 0, 0, 0); }
    const int limh = lim - 4 * hi;
#pragma unroll
    for (int r = 0; r < 16; ++r) { float a0 = __builtin_amdgcn_rcpf(fadd_s(__builtin_amdgcn_exp2f(p0[r]), 1.0f));
        if (MASK) { const int kv = (r & 3) + 8 * (r >> 2); a0 = (kv < limh) ? a0 : 1.0f; }
        p0[r] = a0; }
    float tl[4], th[4];
#pragma unroll
    for (int I = 0; I < 4; ++I) { const float t = fmul_s(fmul_s(p0[4 * I], p0[4 * I + 1]), fmul_s(p0[4 * I + 2], p0[4 * I + 3]));
        auto rr = __builtin_amdgcn_permlane32_swap(__float_as_uint(t), __float_as_uint(t), false, false);
        tl[I] = __uint_as_float(rr[0]); th[I] = __uint_as_float(rr[1]); }
#pragma unroll
    for (int I = 3; I >= 0; --I) { float E = fmul_s(R, hi ? 1.0f : th[I]);
#pragma unroll
        for (int c = 3; c >= 0; --c) { const float P = fmul_s(E, p0[4 * I + c]); p0[4 * I + c] = fsub_s(E, P); E = P; }
        R = fmul_s(R, fmul_s(tl[I], th[I])); }
    const u32x4 pw0 = (u32x4){cvtpk_s(p0[0], p0[1]), cvtpk_s(p0[2], p0[3]), cvtpk_s(p0[4], p0[5]), cvtpk_s(p0[6], p0[7])};
    const u32x4 pw1 = (u32x4){cvtpk_s(p0[8], p0[9]), cvtpk_s(p0[10], p0[11]), cvtpk_s(p0[12], p0[13]), cvtpk_s(p0[14], p0[15])};
    __builtin_amdgcn_sched_barrier(0);
#pragma unroll
    for (int d0 = 0; d0 < 2; ++d0) { s16x4 lo[2], hh[2];
#pragma unroll
        for (int ks = 0; ks < 2; ++ks) {
            asm volatile("ds_read_b64_tr_b16 %0,%1 offset:%c2" : "=&v"(lo[ks]) : "v"(vb), "i"(d0 * 2048 + ks * 1024) : "memory");
            asm volatile("ds_read_b64_tr_b16 %0,%1 offset:%c2" : "=&v"(hh[ks]) : "v"(vb), "i"(d0 * 2048 + ks * 1024 + 512) : "memory"); }
        asm volatile("s_waitcnt lgkmcnt(0)" ::: "memory"); __builtin_amdgcn_sched_barrier(0);
        o[d0] = __builtin_amdgcn_mfma_f32_32x32x16_bf16(__builtin_bit_cast(bf16x8, pw0), (bf16x8){lo[0][0], lo[0][1], lo[0][2], lo[0][3], hh[0][0], hh[0][1], hh[0][2], hh[0][3]}, o[d0], 0, 0, 0);
        o[d0] = __builtin_amdgcn_mfma_f32_32x32x16_bf16(__builtin_bit_cast(bf16x8, pw1), (bf16x8){lo[1][0], lo[1][1], lo[1][2], lo[1][3], hh[1][0], hh[1][1], hh[1][2], hh[1][3]}, o[d0], 0, 0, 0);
    }
}
template <bool META>
__device__ __forceinline__ void wave_unit(int b, int h, int i32, const bf16* Q, const bf16* __restrict__ K, const bf16* __restrict__ V, bf16* O, SBA_LAS unsigned char* wbuf) {
    int tid = threadIdx.x; asm volatile("" : "+v"(tid));
    const int lane = tid & 63, r32 = lane & 31, hi = lane >> 5;
    const size_t rowbase = (size_t)b * AT;
    const size_t qrow0 = META ? (size_t)AMROW : rowbase + 32 * i32;
    const bf16* Qw = Q + qrow0 * AD + h * 64;
    const unsigned lds0 = (unsigned)(uintptr_t)wbuf;
    const bf16* ksrc = K + h * 64 + (size_t)(lane & 31) * AD + (lane >> 5) * 8;
    const bf16* vsrc = V + h * 64 + (size_t)(lane >> 2) * AD + (lane & 3) * 8;
    bf16x8 qr[4];
#pragma unroll
    for (int d0 = 0; d0 < 4; ++d0) qr[d0] = *(const bf16x8*)(Qw + (size_t)r32 * AD + d0 * 16 + hi * 8);
    f32x16 o[2]; o[0] = f32x16{}; o[1] = f32x16{};
    float R = 1.0f;
    const int tmin = 32 * i32, tmax = tmin + 31, tq = tmin + r32;
    const int vb0 = (int)(lds0 + 4096) + ((lane >> 4) & 1) * 32 + (lane & 3) * 8 + (4 * hi + ((lane & 15) >> 2)) * 64;
#define SBA_DMA32(j_, bf_) do { const size_t r_ = ((j_) >= 0) ? rowbase + (size_t)32 * (j_) : (size_t)AMROW; const unsigned d_ = lds0 + (unsigned)(bf_) * 8192u; \
        _Pragma("unroll") for (int i = 0; i < 4; ++i) glds16(ksrc + r_ * AD + i * 16, (unsigned)__builtin_amdgcn_readfirstlane(d_ + i * 1024)); \
        _Pragma("unroll") for (int p = 0; p < 4; ++p) glds16(vsrc + (r_ + 16 * (p & 1)) * AD + (p >> 1) * 32, (unsigned)__builtin_amdgcn_readfirstlane(d_ + 4096 + p * 1024)); } while (0)
    const int jtop = META ? -1 : ((tmax - 1) >> 5);
    SBA_DMA32(jtop, 0);
    if (jtop >= 0) SBA_DMA32(jtop - 1, 1);
    int bf = 0;
    for (int j = jtop; j >= -1; --j) {
        if (j >= 0) asm volatile("s_waitcnt vmcnt(8)" ::: "memory"); else asm volatile("s_waitcnt vmcnt(0)" ::: "memory");
        SBA_LAS const unsigned char* kimg = wbuf + bf * 8192; const int vb = vb0 + bf * 8192;
        if (j < 0) tile32<true>(o, R, qr, kimg, vb, r32, hi, META ? (r32 < 16 ? r32 : 16) : 16);
        else if (32 * j + 31 >= tmin) tile32<true>(o, R, qr, kimg, vb, r32, hi, tq - 32 * j);
        else tile32<false>(o, R, qr, kimg, vb, r32, hi, 32);
        if (__all(R == 0.0f)) break;
        asm volatile("s_waitcnt lgkmcnt(0)" ::: "memory");
        if (j >= 1) SBA_DMA32(j - 2, bf);
        bf ^= 1;
    }
#undef SBA_DMA32
    bf16* Ow = O + qrow0 * AD + h * 64;
    asm volatile("s_waitcnt vmcnt(0) lgkmcnt(0)" ::: "memory");
    { SBA_LAS bf16* stg = (SBA_LAS bf16*)wbuf;
#pragma unroll
      for (int r = 0; r < 16; ++r) { const int orow = crow(r, hi);
#pragma unroll
          for (int d0 = 0; d0 < 2; ++d0) stg[orow * 64 + d0 * 32 + r32] = (bf16)(cvtpk_s(o[d0][r], 0.f) & 0xffffu); }
      asm volatile("s_waitcnt lgkmcnt(0)" ::: "memory");
#pragma unroll
      for (int i = 0; i < 4; ++i) { const int row = i * 8 + (lane >> 3), ch = lane & 7; const u32x4 v = *(SBA_LAS const u32x4*)(stg + row * 64 + ch * 8); *(u32x4*)(Ow + (size_t)row * AD + ch * 8) = v; } }
    asm volatile("s_waitcnt vmcnt(0) lgkmcnt(0)" ::: "memory");
}
__device__ __forceinline__ void phase(SBA_LAS unsigned char* shm, const bf16* Q, const bf16* K, const bf16* V, bf16* O, int G, int bx) {
    const int vcu = (G % 8 == 0) ? (bx % 8) * (G / 8) + bx / 8 : bx;
    const int wid = __builtin_amdgcn_readfirstlane(threadIdx.x >> 6), gwv = vcu * 8 + wid, NGWV = G * 8;
    SBA_LAS unsigned char* wbuf = shm + wid * 16384;
    for (int u = gwv; u < 64 * 128; u += NGWV) { const int bh = u >> 7, i32 = 127 - (u & 127); wave_unit<false>(bh >> 4, bh & 15, i32, Q, K, V, O, wbuf); }
    for (int hm = NGWV - 1 - gwv; hm < 16; hm += NGWV) wave_unit<true>(0, hm, 0, Q, K, V, O, wbuf);
    __syncthreads();
}
}

#ifndef MK_N_LAUNCHES
#define MK_N_LAUNCHES 1
#endif
#ifndef PROBE_A
#define PROBE_A -1
#define PROBE_B -1
#endif
#ifndef ATTN_SIMPLE
#define ATTN_SIMPLE 0
#endif
constexpr int NB = 4, T = 4096, D = 1024, NMETA = 16, NH = 16, HD = 64, FF = 2816, FF2 = 5632;
constexpr int M = NB * T;
constexpr int MROW = M;
constexpr int MR = M + 64;
constexpr float EPS = 1e-6f;
constexpr float C2 = 0.125f * 1.4426950408889634f;
constexpr int NWAVES = 8, NTHREADS = 512, NPHASES = 11;
constexpr size_t WS_WPOOL = 0;
constexpr size_t WS_WUP   = WS_WPOOL + (size_t)4 * 256 * 256 * 2;
constexpr size_t WS_WDOWN = WS_WUP + (size_t)2 * FF2 * D * 2;
constexpr size_t WS_WQKV  = WS_WDOWN + (size_t)2 * D * FF * 2;
constexpr size_t WS_WO    = WS_WQKV + (size_t)3 * D * D * 2;
constexpr size_t WS_HB    = WS_WO + (size_t)D * D * 2;
constexpr size_t WS_U     = WS_HB + (size_t)MR * D * 2;
constexpr size_t WS_HALO  = WS_U + (size_t)MR * FF2 * 2;
constexpr size_t WS_SSQ   = WS_HALO + (size_t)65 * 2 * FF2 * 2;
constexpr size_t WS_HM    = WS_SSQ + (size_t)5 * MR * 4;
constexpr size_t WS_CTL   = WS_HM + (size_t)16 * D * 4;
constexpr size_t CTL_BYTES = 16384;
constexpr size_t WS_END   = WS_CTL + CTL_BYTES;
constexpr size_t ACT_BYTES = (size_t)MR * D * 2;
static_assert(WS_END <= 268435456, "workspace map exceeds 256 MiB");
static_assert(4 * ACT_BYTES <= (size_t)MR * FF2 * 2, "Q|K|V|O overlay fits in U");
constexpr int LDS_MISC_OFF = 131072;
constexpr int LDS_BYTES = 147456;

#define GAS __attribute__((address_space(1)))
#define LAS __attribute__((address_space(3)))
typedef unsigned short bf16;
typedef unsigned v4u __attribute__((ext_vector_type(4)));
typedef unsigned v2u __attribute__((ext_vector_type(2)));
typedef float f32x4 __attribute__((ext_vector_type(4)));
typedef short bf16x8 __attribute__((ext_vector_type(8)));
#define LDS_WAIT() asm volatile("s_waitcnt lgkmcnt(0)" ::: "memory")
__device__ __forceinline__ unsigned pk2(float lo, float hi) { return pg8::cvt_pk_bf16(lo, hi); }
__device__ __forceinline__ float bflo(unsigned w) { return __uint_as_float(w << 16); }
__device__ __forceinline__ float bfhi(unsigned w) { return __uint_as_float(w & 0xffff0000u); }
__device__ __forceinline__ float wave_sum(float v) {
#pragma unroll
    for (int o = 1; o < 64; o <<= 1) v += __shfl_xor(v, o);
    return v;
}
__device__ __forceinline__ float rs_of(float ssq) { return __builtin_amdgcn_rsqf(ssq * (1.0f / (float)D) + EPS); }

#define RLX_AGENT __ATOMIC_RELAXED, __HIP_MEMORY_SCOPE_AGENT
#define XB_TMO      128
#define XB_XCNT(j)  (256  + 64 * (j))
#define XB_XSUB(j)  (1280 + 64 * (j))
#define XB_XGEN(j)  (2304 + 64 * (j))
#define XB_TOP      3328
#define XB_TOPGEN   3392
#define XCD_BAR_WORDS 3456
#define XB_SPIN_CAP (1u << 18)

__device__ __forceinline__ unsigned xb_ld(unsigned* p)              { return __hip_atomic_load(p, __ATOMIC_RELAXED, __HIP_MEMORY_SCOPE_AGENT); }
__device__ __forceinline__ unsigned xb_add(unsigned* p, unsigned v) { return __hip_atomic_fetch_add(p, v, __ATOMIC_RELAXED, __HIP_MEMORY_SCOPE_AGENT); }
__device__ __forceinline__ unsigned xb_xcc_id() { return (unsigned)__builtin_amdgcn_s_getreg((3 << 11) | 20) & 0xFu; }
#define XB_SPIN(cond, bar) do { unsigned _sp = 0; while (cond) { __builtin_amdgcn_s_sleep(1); \
    if ((++_sp & 255u) == 0u) { if (xb_ld(&(bar)[XB_TMO])) break; if (_sp > XB_SPIN_CAP) { atomicAdd(&(bar)[XB_TMO], 1u); break; } } } } while (0)

struct XcdBarrier {
    unsigned* bar; unsigned x;
    volatile LAS unsigned* st;
};

__device__ __forceinline__ XcdBarrier xcd_barrier_post(unsigned* bar, volatile LAS unsigned* st) {
    XcdBarrier b; b.bar = bar; b.x = xb_xcc_id(); b.st = st;
    if (threadIdx.x == 0) (void)xb_add(&bar[XB_XCNT(b.x)], 1u);
    return b;
}
__device__ __forceinline__ void xcd_barrier_complete(unsigned* bar, unsigned x, unsigned& nloc, unsigned& nx) {
    const unsigned G = gridDim.x * gridDim.y * gridDim.z;
    unsigned sum, cnt, mine, sp = 0u;
    for (;;) {
        sum = 0u; cnt = 0u; mine = 0u;
#pragma unroll
        for (unsigned j = 0; j < 16; ++j) { const unsigned c = xb_ld(&bar[XB_XCNT(j)]); sum += c; cnt += (c > 0u) ? 1u : 0u; mine = (j == x) ? c : mine; }
        if (sum == G) break;
        __builtin_amdgcn_s_sleep(1);
        if ((++sp & 255u) == 0u) { if (xb_ld(&bar[XB_TMO])) break; if (sp > XB_SPIN_CAP) { atomicAdd(&bar[XB_TMO], 1u); break; } }
    }
    nloc = mine > 0u ? mine : 1u; nx = cnt > 0u ? cnt : 1u;
}

__device__ __forceinline__ void xcd_barrier(const XcdBarrier& b) {
    asm volatile("s_waitcnt vmcnt(0)" ::: "memory");
    __syncthreads();
    if (threadIdx.x == 0) {
        unsigned* bar = b.bar;
        __builtin_amdgcn_s_waitcnt(0);
        unsigned nloc = b.st[0], nx = b.st[1];
        if (nloc == 0u) { xcd_barrier_complete(bar, b.x, nloc, nx); b.st[0] = nloc; b.st[1] = nx; }
        const unsigned old = xb_add(&bar[XB_XSUB(b.x)], 1u);
        const unsigned gen = old / nloc;
        if (old + 1u == (gen + 1u) * nloc) {
            __builtin_amdgcn_fence(__ATOMIC_RELEASE, "agent");
            asm volatile("s_waitcnt vmcnt(0)" ::: "memory");
            const unsigned og = xb_add(&bar[XB_TOP], 1u);
            const unsigned tg = og / nx;
            if (og + 1u == (tg + 1u) * nx) xb_add(&bar[XB_TOPGEN], 1u);
            else XB_SPIN(xb_ld(&bar[XB_TOPGEN]) == tg, bar);
            __builtin_amdgcn_fence(__ATOMIC_ACQUIRE, "agent");
            xb_add(&bar[XB_XGEN(b.x)], 1u);
            asm volatile("s_waitcnt vmcnt(0)" ::: "memory");
        } else {
            XB_SPIN(xb_ld(&bar[XB_XGEN(b.x)]) == gen, bar);
            __builtin_amdgcn_fence(__ATOMIC_ACQUIRE, "agent");
            asm volatile("s_waitcnt vmcnt(0)" ::: "memory");
        }
    }
    __syncthreads();
}


__device__ __forceinline__ void p0_transpose_item(const float* W, int K, int N, bf16* WT, int row_off, const float* gain, LAS float* scr, int item, int lane) {
    const int nblk = N / 32, kb = item / nblk, nb = item % nblk, k0 = 64 * kb, n0 = 32 * nb;
    const int c4 = (lane & 7) * 4;
    f32x4 w[8];
#pragma unroll
    for (int i = 0; i < 8; ++i) { const int kk = 8 * i + (lane >> 3); w[i] = __builtin_nontemporal_load((const f32x4*)(W + (size_t)(k0 + kk) * N + n0 + c4)); }
#pragma unroll
    for (int i = 0; i < 8; ++i) { const int kk = 8 * i + (lane >> 3); const float gk = gain ? gain[k0 + kk] : 1.f; LAS float* d = scr + kk * 33 + c4;
        d[0] = w[i][0] * gk; d[1] = w[i][1] * gk; d[2] = w[i][2] * gk; d[3] = w[i][3] * gk; }
    LDS_WAIT(); asm volatile("" ::: "memory");
    const int c = lane & 7;
#pragma unroll
    for (int j = 0; j < 4; ++j) { const int n = (lane >> 3) + 8 * j; const LAS float* s = scr + (8 * c) * 33 + n;
        v4u o; o.x = pk2(s[0 * 33], s[1 * 33]); o.y = pk2(s[2 * 33], s[3 * 33]); o.z = pk2(s[4 * 33], s[5 * 33]); o.w = pk2(s[6 * 33], s[7 * 33]);
        *(v4u*)(WT + (size_t)(row_off + n0 + n) * K + k0 + 8 * c) = o; }
    LDS_WAIT(); asm volatile("" ::: "memory");
}
template <bool IS_META, int NR>
__device__ __forceinline__ void p0_diff8(const float* __restrict__ x, const float* __restrict__ meta, const float* __restrict__ g0, const float* __restrict__ ssq0, bf16* __restrict__ DIFF, int b, int t0, int lane) {
    f32x4 gv[4];
#pragma unroll
    for (int j = 0; j < 4; ++j) gv[j] = *(const f32x4*)(g0 + 4 * lane + 256 * j);
    float myrs = 0.f;
    { const int t = t0 - 15 + lane; if (lane < 15 + NR && t >= -16) myrs = rs_of(ssq0[(t >= 0) ? (b * T + t) : (M + 16 + t)]); }
#define P0_RS(dt) __builtin_bit_cast(float, __builtin_amdgcn_readlane(__builtin_bit_cast(int, myrs), 15 + (dt)))
#define P0_SRC(t_) (((t_) >= 0) ? x + ((size_t)b * T + (t_)) * D : meta + (size_t)(16 + (t_)) * D)
    const f32x4 z4 = {0.f, 0.f, 0.f, 0.f};
    f32x4 S[4];
#pragma unroll
    for (int j = 0; j < 4; ++j) { S[j] = z4; const int w = 2 << j;
#pragma unroll
        for (int i = 1; i < w; ++i) { const int t = t0 - i; if (!IS_META || t >= -16) S[j] += *(const f32x4*)(P0_SRC(t) + 4 * lane + 256 * j) * (P0_RS(-i) * gv[j]); } }
#pragma unroll
    for (int r = 0; r < NR; ++r) {
        const int t = t0 + r; const float* src = P0_SRC(t); const float rs = P0_RS(r);
        const size_t orow = IS_META ? (size_t)(M + 16 + t) : ((size_t)b * T + t);
#pragma unroll
        for (int j = 0; j < 4; ++j) { const int w = 2 << j;
            const f32x4 n = *(const f32x4*)(src + 4 * lane + 256 * j) * (rs * gv[j]);
            S[j] += n;
            const int pos1 = t + 17;
            const float inv = IS_META ? 1.0f / (float)(pos1 < w ? pos1 : w) : 1.0f / (float)w;
            const f32x4 d = S[j] * inv - n; v2u o; o.x = pk2(d[0], d[1]); o.y = pk2(d[2], d[3]);
            *(v2u*)(DIFF + orow * D + 4 * lane + 256 * j) = o;
            const int to = t - w + 1;
            if (r < NR - 1 && (!IS_META || to >= -16)) S[j] -= *(const f32x4*)(P0_SRC(to) + 4 * lane + 256 * j) * (P0_RS(r - w + 1) * gv[j]);
        }
    }
#undef P0_RS
#undef P0_SRC
}
template <bool IS_META>
__device__ __forceinline__ void diff_block(const float* __restrict__ x, const float* __restrict__ meta, const float* __restrict__ g0, const float* __restrict__ ssq0, bf16* __restrict__ DIFF,
                                           int b, int t0, int j, LAS float* tile, int tid) {
    constexpr int NOUT = IS_META ? 16 : 64;
    const int w = 2 << j, tlo = IS_META ? t0 : t0 - (w - 1), nrows = IS_META ? NOUT : NOUT + w - 1;
    const int c4 = tid & 63, rp = tid >> 6;
    const f32x4 gv = *(const f32x4*)(g0 + 256 * j + 4 * c4);
#pragma unroll 5
    for (int lr = rp; lr < nrows; lr += 8) { const int t = tlo + lr;
        const float* src = (t >= 0) ? x + ((size_t)b * T + t) * D : meta + (size_t)(16 + t) * D;
        const float rs = rs_of(ssq0[(t >= 0) ? (b * T + t) : (M + 16 + t)]);
        *(LAS f32x4*)(tile + (size_t)lr * 256 + 4 * c4) = *(const f32x4*)(src + 256 * j + 4 * c4) * (rs * gv); }
    __syncthreads();
    if (rp * 8 < NOUT) {
        const int tf = t0 + 8 * rp; const f32x4 z4 = {0.f, 0.f, 0.f, 0.f}; f32x4 S = z4;
        for (int i = 1; i < w; ++i) { const int t = tf - i; if (t >= tlo) S += *(const LAS f32x4*)(tile + (size_t)(t - tlo) * 256 + 4 * c4); }
#pragma unroll
        for (int r = 0; r < 8; ++r) { const int t = tf + r; const f32x4 n = *(const LAS f32x4*)(tile + (size_t)(t - tlo) * 256 + 4 * c4);
            S += n;
            const int pos1 = t + 17; const float inv = IS_META ? 1.0f / (float)(pos1 < w ? pos1 : w) : 1.0f / (float)w;
            const f32x4 d = S * inv - n; v2u o; o.x = pk2(d[0], d[1]); o.y = pk2(d[2], d[3]);
            const size_t orow = IS_META ? (size_t)(M + 16 + t) : ((size_t)b * T + t);
            __builtin_nontemporal_store(o, (v2u*)(DIFF + orow * D + 256 * j + 4 * c4));
            const int to = t - w + 1; if (to >= tlo) S -= *(const LAS f32x4*)(tile + (size_t)(to - tlo) * 256 + 4 * c4); }
    }
    __syncthreads();
}
template <class F>
__device__ __forceinline__ void thin_item(const bf16* A, int lda, const bf16* Bt, int K, int n0, int lane, int wave, LAS float* red, F epi) {
    const int m = lane & 15, kq = lane >> 4, kw = K / NWAVES;
    const bf16* ap = A + (size_t)m * lda + wave * kw + kq * 8; const bf16* bp = Bt + (size_t)(n0 + m) * K + wave * kw + kq * 8;
    f32x4 acc = {0.f, 0.f, 0.f, 0.f};
#pragma unroll 12
    for (int ks = 0; ks < kw; ks += 32) { const bf16x8 a = *(const bf16x8*)(ap + ks); const bf16x8 bb = *(const bf16x8*)(bp + ks); acc = __builtin_amdgcn_mfma_f32_16x16x32_bf16(a, bb, acc, 0, 0, 0); }
    *(LAS f32x4*)(red + (wave * 64 + lane) * 4) = acc;
    __syncthreads();
    if (wave == 0) {
        f32x4 sum = acc;
#pragma unroll
        for (int w = 1; w < NWAVES; ++w) sum += *(const LAS f32x4*)(red + (w * 64 + lane) * 4);
        epi(4 * kq, n0 + m, sum);
    }
    __syncthreads();
}
__device__ __forceinline__ void thin_res_epi(const float* base, float* hm, bf16* HB, float* ssq, const float* cscale, int row4, int col, const f32x4 acc) {
    const float cs = cscale ? cscale[col] : 1.f; float q[4];
#pragma unroll
    for (int i = 0; i < 4; ++i) { const int r = row4 + i; const float o = base[(size_t)r * D + col] + acc[i] * cs; hm[(size_t)r * D + col] = o; if (HB) { const bf16 ob = (bf16)(pk2(o, 0.f) & 0xffffu);
#pragma unroll
            for (int bb = 0; bb < NB; ++bb) HB[((size_t)bb * (T + 16) + r) * D + col] = ob; }          q[i] = o * o; }
#pragma unroll
    for (int i = 0; i < 4; ++i) { float s = q[i]; s += __shfl_xor(s, 1); s += __shfl_xor(s, 2); s += __shfl_xor(s, 4); s += __shfl_xor(s, 8); if ((col & 15) == 0) atomicAdd(ssq + MROW + row4 + i, s); }
}
__device__ __forceinline__ int upperm(int c) { return c < FF ? (c >> 7) * 256 + (c & 127) : ((c - FF) >> 7) * 256 + 128 + ((c - FF) & 127); }
__device__ __forceinline__ void thin_up_convgate(const bf16* A, const bf16* Wt, const float* ssq_in, const float* cw, const float* cb, bf16* GM, int it, int lane, int wave, LAS float* red) {
    const int m = lane & 15, kq = lane >> 4, kw = D / NWAVES, j0 = 16 * it;
    const bf16* ap = A + (size_t)m * D + wave * kw + kq * 8;
    const bf16* bg_ = Wt + (size_t)(upperm(j0) + m) * D + wave * kw + kq * 8; const bf16* bv_ = Wt + (size_t)(upperm(FF + j0) + m) * D + wave * kw + kq * 8;
    f32x4 ag = {0.f, 0.f, 0.f, 0.f}, av = {0.f, 0.f, 0.f, 0.f};
#pragma unroll
    for (int ks = 0; ks < kw; ks += 32) { const bf16x8 a = *(const bf16x8*)(ap + ks);
        ag = __builtin_amdgcn_mfma_f32_16x16x32_bf16(a, *(const bf16x8*)(bg_ + ks), ag, 0, 0, 0); av = __builtin_amdgcn_mfma_f32_16x16x32_bf16(a, *(const bf16x8*)(bv_ + ks), av, 0, 0, 0); }
    *(LAS f32x4*)(red + (wave * 64 + lane) * 8) = ag; *(LAS f32x4*)(red + (wave * 64 + lane) * 8 + 4) = av;
    __syncthreads();
    if (wave == 0) {
#pragma unroll
        for (int w = 1; w < NWAVES; ++w) { ag += *(const LAS f32x4*)(red + (w * 64 + lane) * 8); av += *(const LAS f32x4*)(red + (w * 64 + lane) * 8 + 4); }
        const int ch = j0 + m; float ug[4], uv[4];
#pragma unroll
        for (int i = 0; i < 4; ++i) { const float rs = rs_of(ssq_in[MROW + 4 * kq + i]); ug[i] = ag[i] * rs; uv[i] = av[i] * rs; }
        float h1g = __shfl_up(ug[3], 16), h2g = __shfl_up(ug[2], 16), h1v = __shfl_up(uv[3], 16), h2v = __shfl_up(uv[2], 16);
        if (kq == 0) { h1g = 0.f; h2g = 0.f; h1v = 0.f; h2v = 0.f; }
        const float wg0 = cw[ch], wg1 = cw[FF2 + ch], wg2 = cw[2 * FF2 + ch], bgc = cb[ch], wv0 = cw[FF + ch], wv1 = cw[FF2 + FF + ch], wv2 = cw[2 * FF2 + FF + ch], bvc = cb[FF + ch];
#pragma unroll
        for (int i = 0; i < 4; ++i) {
            const float p1g = i >= 1 ? ug[i - 1] : h1g, p2g = i >= 2 ? ug[i - 2] : (i == 1 ? h1g : h2g), p1v = i >= 1 ? uv[i - 1] : h1v, p2v = i >= 2 ? uv[i - 2] : (i == 1 ? h1v : h2v);
            const float gc = bgc + wg0 * p2g + wg1 * p1g + wg2 * ug[i], vc = bvc + wv0 * p2v + wv1 * p1v + wv2 * uv[i];
            const float o = gc * __builtin_amdgcn_rcpf(1.0f + __builtin_amdgcn_exp2f(-1.4426950408889634f * gc)) * vc;
            GM[(size_t)(4 * kq + i) * FF + ch] = (bf16)(pk2(o, 0.f) & 0xffffu);
        }
    }
    __syncthreads();
}
struct ConvW { float wg[3][8], bg[8], wv[3][8], bv[8]; };
__device__ __forceinline__ void unpack8(const v4u w, float (&f)[8]) { f[0] = bflo(w.x); f[1] = bfhi(w.x); f[2] = bflo(w.y); f[3] = bfhi(w.y); f[4] = bflo(w.z); f[5] = bfhi(w.z); f[6] = bflo(w.w); f[7] = bfhi(w.w); }
__device__ __forceinline__ void convgate_walk(bf16* U, int row0, int nrows, int ch, const float* cw, const float* cb, v4u pg2, v4u pv2, v4u pg1, v4u pv1) {
    float wg[3][8], wv[3][8], bg[8], bv[8];
#pragma unroll
    for (int k = 0; k < 3; ++k)
#pragma unroll
        for (int i = 0; i < 8; ++i) { wg[k][i] = cw[k * FF2 + ch + i]; wv[k][i] = cw[k * FF2 + FF + ch + i]; }
#pragma unroll
    for (int i = 0; i < 8; ++i) { bg[i] = cb[ch + i]; bv[i] = cb[FF + ch + i]; }
    float g2[8], v2[8], g1[8], v1[8];
    unpack8(pg2, g2); unpack8(pv2, v2); unpack8(pg1, g1); unpack8(pv1, v1);
    bf16* p = U + (size_t)row0 * FF2 + ch;
    for (int r0 = 0; r0 < nrows; r0 += 4, p += 4 * FF2) {
        v4u ug[4], uv[4];
#pragma unroll
        for (int q = 0; q < 4; ++q) { ug[q] = *(const v4u*)(p + (size_t)q * FF2); uv[q] = *(const v4u*)(p + (size_t)q * FF2 + FF); }
#pragma unroll
        for (int q = 0; q < 4; ++q) {
            float g0[8], v0[8], o[8]; unpack8(ug[q], g0); unpack8(uv[q], v0);
#pragma unroll
            for (int i = 0; i < 8; ++i) {
                const float gc = bg[i] + wg[0][i] * g2[i] + wg[1][i] * g1[i] + wg[2][i] * g0[i];
                const float vc = bv[i] + wv[0][i] * v2[i] + wv[1][i] * v1[i] + wv[2][i] * v0[i];
                const float sg = gc * __builtin_amdgcn_rcpf(1.0f + __builtin_amdgcn_exp2f(-1.4426950408889634f * gc));
                o[i] = sg * vc; g2[i] = g1[i]; v2[i] = v1[i]; g1[i] = g0[i]; v1[i] = v0[i];
            }
            v4u w; w.x = pk2(o[0], o[1]); w.y = pk2(o[2], o[3]); w.z = pk2(o[4], o[5]); w.w = pk2(o[6], o[7]);
            *(v4u*)(p + (size_t)q * FF2) = w;
        }
    }
}
__device__ __forceinline__ void convgate_phase(bf16* U, const bf16* HALO, const float* cw, const float* cb, int G, int tid) {
    const v4u z = {0u, 0u, 0u, 0u};
    for (int item = blockIdx.x; item < 256; item += G) {
        const int pm = item >> 2, cq = item & 3, rq = tid / 88, cv = tid % 88, ch = 704 * cq + 8 * cv, row0 = 256 * pm + 64 * rq;
        v4u pg2 = z, pv2 = z, pg1 = z, pv1 = z;
        if (tid < 352) {
            const bf16* h2; const bf16* h1;
            if (rq > 0) { h2 = U + (size_t)(row0 - 2) * FF2; h1 = h2 + FF2; }
            else { const int slot = (pm % 16 == 0) ? 64 : pm - 1; h2 = HALO + (size_t)slot * 2 * FF2; h1 = h2 + FF2; }
            pg2 = *(const v4u*)(h2 + ch); pv2 = *(const v4u*)(h2 + FF + ch); pg1 = *(const v4u*)(h1 + ch); pv1 = *(const v4u*)(h1 + FF + ch);
        }
        __syncthreads();
        if (tid < 352) convgate_walk(U, row0, 64, ch, cw, cb, pg2, pv2, pg1, pv1);
        __syncthreads();
    }
    if (blockIdx.x == G - 1 && tid < 352) convgate_walk(U, MROW, 16, 8 * tid, cw, cb, z, z, z, z);
}
__device__ __forceinline__ void attn_simple(const bf16* Q, const bf16* K, const bf16* V, bf16* O, int first, int nblk, int brank, int tid) {
    const int total = NB * NH * T + NH * NMETA;
    for (int base = first + brank * NTHREADS; base < total; base += nblk * NTHREADS) {
        const int idx = base + tid; const bool valid = idx < total;
        int b = 0, h = 0, npos = 0; size_t qrow = 0;
        if (valid) { if (idx < NB * NH * T) { b = idx / (NH * T); h = (idx / T) % NH; const int t = idx % T; qrow = (size_t)b * T + t; npos = NMETA + t; }
                     else { const int mi = idx - NB * NH * T; h = mi / NMETA; const int t = mi % NMETA; qrow = (size_t)MROW + t; npos = t; } }
        float q[64], o[64];
#pragma unroll
        for (int c = 0; c < 8; ++c) { const v4u w = *(const v4u*)(Q + qrow * D + h * HD + 8 * c); float f[8]; unpack8(w, f);
#pragma unroll
            for (int i = 0; i < 8; ++i) { q[8 * c + i] = f[i]; o[8 * c + i] = 0.f; } }
        int pmax = npos;
#pragma unroll
        for (int s = 1; s < 64; s <<= 1) { const int other = __shfl_xor(pmax, s); pmax = other > pmax ? other : pmax; }
        float carry = 1.f;
        for (int p = pmax - 1; p >= 0; --p) {
            const size_t krow = (p >= NMETA) ? ((size_t)b * T + (p - NMETA)) : (size_t)(MROW + p);
            const bf16* kp = K + krow * D + h * HD; const bf16* vp = V + krow * D + h * HD;
            float z = 0.f;
#pragma unroll
            for (int c = 0; c < 8; ++c) { const v4u w = *(const v4u*)(kp + 8 * c); float f[8]; unpack8(w, f);
#pragma unroll
                for (int i = 0; i < 8; ++i) z += q[8 * c + i] * f[i]; }
            z = fminf(fmaxf(z, -80.f), 80.f);
            const float e = __builtin_amdgcn_exp2f(-z), r = __builtin_amdgcn_rcpf(1.0f + e);
            const bool act = p < npos;
            const float a = act ? r * carry : 0.f; carry = act ? carry * (e * r) : carry;
#pragma unroll
            for (int c = 0; c < 8; ++c) { const v4u w = *(const v4u*)(vp + 8 * c); float f[8]; unpack8(w, f);
#pragma unroll
                for (int i = 0; i < 8; ++i) o[8 * c + i] += a * f[i]; }
        }
        if (valid) {
#pragma unroll
            for (int c = 0; c < 8; ++c) { v4u w; w.x = pk2(o[8 * c], o[8 * c + 1]); w.y = pk2(o[8 * c + 2], o[8 * c + 3]); w.z = pk2(o[8 * c + 4], o[8 * c + 5]); w.w = pk2(o[8 * c + 6], o[8 * c + 7]);
                *(v4u*)(O + qrow * D + h * HD + 8 * c) = w; }
        }
    }
}

struct Args { const float* in[15]; float* out; unsigned char* ws; int ph_lo, ph_hi; };
__global__ void __launch_bounds__(NTHREADS, 2) yoco_fwd(Args args) {
    extern __shared__ __attribute__((aligned(16))) unsigned char lds_raw[];
    LAS unsigned char* lds = (LAS unsigned char*)lds_raw;
    cg::grid_group grid = cg::this_grid();
    asm volatile("s_nop 0");
    const int tid = threadIdx.x, lane = tid & 63, wave = __builtin_amdgcn_readfirstlane(tid >> 6);
    const int G = gridDim.x, bx = blockIdx.x;
    const int gw = bx * NWAVES + wave, NGW = G * NWAVES;
    const int tw = (G - 1 - bx) * NWAVES + wave;
    const float* x = args.in[0]; const float* meta = args.in[1]; const float* mix_norm = args.in[2]; const float* ffn_norm = args.in[3];
    const float* pool_w = args.in[4]; const float* pool_scale = args.in[5]; const float* kv_norm = args.in[6]; const float* w_kv = args.in[7];
    const float* w_q = args.in[8]; const float* w_o = args.in[9]; const float* w_up = args.in[10]; const float* conv_w = args.in[11];
    const float* conv_b = args.in[12]; const float* w_down = args.in[13]; const float* final_norm = args.in[14];
    float* out = args.out; unsigned char* ws = args.ws;
    bf16* Wpool_t = (bf16*)(ws + WS_WPOOL); bf16* Wup_t = (bf16*)(ws + WS_WUP); bf16* Wdown_t = (bf16*)(ws + WS_WDOWN); bf16* Wqkv_t = (bf16*)(ws + WS_WQKV); bf16* Wo_t = (bf16*)(ws + WS_WO);
    bf16* HB = (bf16*)(ws + WS_HB); bf16* U = (bf16*)(ws + WS_U); bf16* GM = (bf16*)(ws + WS_HALO);
    bf16* DIFF = U; bf16* QB = U; bf16* KB = (bf16*)(ws + WS_U + ACT_BYTES); bf16* VB = (bf16*)(ws + WS_U + 2 * ACT_BYTES); bf16* OB = (bf16*)(ws + WS_U + 3 * ACT_BYTES);
    float* SSQ = (float*)(ws + WS_SSQ); float* HM = (float*)(ws + WS_HM);
    float* ssq1 = SSQ, *ssq2 = SSQ + MR, *ssq3 = SSQ + 2 * MR, *ssq4 = SSQ + 3 * MR, *ssq0 = SSQ + 4 * MR;
    const int lo = args.ph_lo, hi = args.ph_hi;
#define IN(k) (lo <= (k) && (k) < hi)
#if PROBE_A >= 0
    unsigned long long tprev = __builtin_amdgcn_s_memrealtime(), dA = 0, dB = 0;
#define PROBE_MARK(k) do { if (bx == 0 && tid == 0) { const unsigned long long now_ = __builtin_amdgcn_s_memrealtime(); if ((k) == PROBE_A) dA = now_ - tprev; if ((k) == PROBE_B) dB = now_ - tprev; tprev = now_; } } while (0)
#else
#define PROBE_MARK(k) do { } while (0)
#endif
    volatile LAS unsigned* bst = (volatile LAS unsigned*)(lds + LDS_MISC_OFF);
    if (tid < 2) bst[tid] = 0u;
    __syncthreads();
    XcdBarrier bar = xcd_barrier_post((unsigned*)(ws + WS_CTL), bst);
    if (lo < 0) grid.sync();
#define SEAM(k) do { if (IN(k) && IN((k) + 1)) xcd_barrier(bar); PROBE_MARK(k); } while (0)

    constexpr int I_POOL = 4 * 32, I_UP = (D / 64) * (FF2 / 32), I_DOWN = (FF / 64) * (D / 32), I_Q = (D / 64) * (D / 32), I_KV = (D / 64) * (2 * D / 32), I_O = I_Q;
    if (IN(0)) {
        LAS float* scr = (LAS float*)(lds + wave * 16384);
        const int NWK = NGW;
        for (int r0 = gw * 4; r0 < M + 16; r0 += NWK * 4) {
            f32x4 v[4][4];
#pragma unroll
            for (int q = 0; q < 4; ++q) { const int r = r0 + q; const float* src = (r < M) ? x + (size_t)r * D : meta + (size_t)(r - M) * D;
#pragma unroll
                for (int j = 0; j < 4; ++j) v[q][j] = *(const f32x4*)(src + 4 * lane + 256 * j); }
#pragma unroll
            for (int q = 0; q < 4; ++q) { float sacc = 0.f;
#pragma unroll
                for (int j = 0; j < 4; ++j) sacc += (v[q][j][0] * v[q][j][0] + v[q][j][1] * v[q][j][1]) + (v[q][j][2] * v[q][j][2] + v[q][j][3] * v[q][j][3]);
                sacc = wave_sum(sacc); if (lane == 0) ssq0[r0 + q] = sacc; }
        }
        for (int it = gw; it < I_POOL + I_UP; it += NWK) {
            if (it < I_POOL) { const int g = it / 32; p0_transpose_item(pool_w + (size_t)g * 65536, 256, 256, Wpool_t, 256 * g, nullptr, scr, it % 32, lane); }
            else { const int itm = it - I_POOL, n0 = 32 * (itm % (FF2 / 32)); p0_transpose_item(w_up, D, FF2, Wup_t, upperm(n0) - n0, ffn_norm, scr, itm, lane); }
        }
        for (int i = bx * NTHREADS + tid; i < 4 * MR; i += G * NTHREADS) SSQ[i] = 0.f;
    }
    SEAM(0);
    if (IN(1)) {
        for (int it = bx; it < 4 * (M / 64); it += G) { const int rb = it % (M / 64), j = it / (M / 64); diff_block<false>(x, meta, mix_norm, ssq0, DIFF, rb / (T / 64), (rb % (T / 64)) * 64, j, (LAS float*)lds, tid); }
        for (int j = G - 1 - bx; j < 4; j += G) diff_block<true>(x, meta, mix_norm, ssq0, DIFF, 0, -16, j, (LAS float*)lds, tid);
    }
    SEAM(1);
    if (IN(2)) {
        pg8::Gemm g{DIFF, Wpool_t, M, D, 256, D, 256, 0}; pg8::StaticOrder S; S.init(M, D, G, bx);
        pg8::EpiRes E{x, nullptr, nullptr, HB, ssq1, pool_scale, D};
        pg8::gemm_phase<pg8::EpiRes, pg8::StaticOrder, false, true>(lds, g, S, E);
        for (int it = G - 1 - bx; it < D / 16; it += G) { const int n0 = it * 16, gsel = n0 / 256;
            thin_item(DIFF + (size_t)MROW * D + 256 * gsel, D, Wpool_t, 256, n0, lane, wave, (LAS float*)lds, [&](int row4, int col, const f32x4 acc) { thin_res_epi(meta, HM, HB, ssq1, pool_scale, row4, col, acc); }); }
    }
    SEAM(2);
    auto deferred_weights = [&]() {
        LAS float* scr = (LAS float*)(lds + wave * 16384);
        const int nlow = G, idx = bx;
        constexpr int NDEF = I_UP + 2 * I_DOWN + I_Q + I_KV + I_O;
        for (int it = idx * NWAVES + wave; it < NDEF; it += nlow * NWAVES) {
            int r = it;
            if (r < I_UP) { const int n0 = 32 * (r % (FF2 / 32)); p0_transpose_item(w_up + (size_t)D * FF2, D, FF2, Wup_t + (size_t)FF2 * D, upperm(n0) - n0, ffn_norm + D, scr, r, lane); continue; } r -= I_UP;
            if (r < 2 * I_DOWN) { const int l2 = r / I_DOWN; p0_transpose_item(w_down + (size_t)l2 * FF * D, FF, D, Wdown_t + (size_t)l2 * D * FF, 0, nullptr, scr, r % I_DOWN, lane); continue; } r -= 2 * I_DOWN;
            if (r < I_Q) { p0_transpose_item(w_q, D, D, Wqkv_t, 0, mix_norm + D, scr, r, lane); continue; } r -= I_Q;
            if (r < I_KV) { p0_transpose_item(w_kv, D, 2 * D, Wqkv_t, D, kv_norm, scr, r, lane); continue; } r -= I_KV;
            p0_transpose_item(w_o, D, D, Wo_t, 0, nullptr, scr, r, lane);
        }
    };
#define FFN_PHASES(l, pb, ssq_in, ssq_out) do { \
          \
        if (IN(pb)) { \
            const bf16* Wt = Wup_t + (size_t)(l) * FF2 * D; const float* cw_ = conv_w + (size_t)(l) * 3 * FF2; const float* cb_ = conv_b + (size_t)(l) * FF2; \
            pg8::Gemm g{HB, Wt, 68 * 256, FF2, D, D, 0, 2}; pg8::StaticOrder S; S.init(68 * 256, FF2, G, bx); \
            pg8::EpiConvGate E{U, ssq_in, cw_, cb_}; \
            pg8::gemm_phase<pg8::EpiConvGate, pg8::StaticOrder, true, true>(lds, g, S, E); \
            { const int rem_ = (68 * 22) % G, nlow_ = rem_ ? G - rem_ : G, idx_ = rem_ ? bx - rem_ : bx;        \
              if (idx_ >= 0) for (int it = idx_; it < FF / 16; it += nlow_) thin_up_convgate(HB, Wt, ssq_in, cw_, cb_, GM, it, lane, wave, (LAS float*)lds); } \
            if ((l) == 0) deferred_weights(); \
        } \
        SEAM(pb); \
          \
        if (IN(pb + 1)) { \
            const bf16* Wt = Wdown_t + (size_t)(l) * D * FF; \
            pg8::Gemm g{U, Wt, M, D, FF, FF, 0, 0}; pg8::StaticOrder S; S.init(M, D, G, bx); \
            pg8::EpiRes E{nullptr, HB, nullptr, HB, ssq_out, nullptr, D}; \
            pg8::gemm_phase<pg8::EpiRes, pg8::StaticOrder, false, true>(lds, g, S, E); \
            if ((l) == 0) \
                for (int it = G - 1 - bx; it < D / 16; it += G) \
                    thin_item(GM, FF, Wt, FF, it * 16, lane, wave, (LAS float*)lds, [&](int row4, int col, const f32x4 acc) { thin_res_epi(HM, HM, HB, ssq_out, nullptr, row4, col, acc); }); \
        } \
        SEAM(pb + 1); } while (0)
    FFN_PHASES(0, 3, ssq1, ssq2);
    if (IN(5)) {
        pg8::Gemm g{HB, Wqkv_t, M, 3 * D, D, D, 0, 1}; pg8::StaticOrder S; S.init(M, 3 * D, G, bx);
        pg8::EpiRsBf16 E{QB, D, ssq2, D, ACT_BYTES / 2, C2, nullptr};
        pg8::gemm_phase<pg8::EpiRsBf16, pg8::StaticOrder, true, true>(lds, g, S, E);
        for (int it = G - 1 - bx; it < 3 * D / 16; it += G)
            thin_item(HB, D, Wqkv_t, D, it * 16, lane, wave, (LAS float*)lds, [&](int row4, int col, const f32x4 acc) {
                const int tsel = col / D, cc = col % D; bf16* dst = QB + (size_t)tsel * (ACT_BYTES / 2);
#pragma unroll
                for (int i = 0; i < 4; ++i) { const int r = row4 + i; const float v = acc[i] * rs_of(ssq2[MROW + r]) * (tsel == 0 ? C2 : 1.f); dst[(size_t)(MROW + r) * D + cc] = (bf16)(pk2(v, 0.f) & 0xffffu); } });
        for (int i = bx * NTHREADS + tid; i < 2 * 48 * D / 8; i += G * NTHREADS) { const int which = i / (48 * D / 8), off = i % (48 * D / 8);
            *(v4u*)((which ? VB : KB) + (size_t)(MROW + 16) * D + (size_t)off * 8) = (v4u){0u, 0u, 0u, 0u}; }
    }
    SEAM(5);
    if (IN(6)) {
#if ATTN_SIMPLE
        attn_simple(QB, KB, VB, OB, 0, G, bx, tid);
#else
        sba::phase(lds, QB, KB, VB, OB, G, bx);
#endif
    }
    SEAM(6);
    if (IN(7)) {
        pg8::Gemm g{OB, Wo_t, M, D, D, D, 0, 0}; pg8::StaticOrder S; S.init(M, D, G, bx);
        pg8::EpiRes E{nullptr, HB, nullptr, HB, ssq3, nullptr, D};
        pg8::gemm_phase<pg8::EpiRes, pg8::StaticOrder, false, true>(lds, g, S, E);
        for (int it = G - 1 - bx; it < D / 16; it += G)
            thin_item(OB + (size_t)MROW * D, D, Wo_t, D, it * 16, lane, wave, (LAS float*)lds, [&](int row4, int col, const f32x4 acc) { thin_res_epi(HM, HM, HB, ssq3, nullptr, row4, col, acc); });
    }
    SEAM(7);
    FFN_PHASES(1, 8, ssq3, ssq4);
#undef FFN_PHASES
    if (IN(10)) {
        f32x4 gv[4];
#pragma unroll
        for (int j = 0; j < 4; ++j) gv[j] = *(const f32x4*)(final_norm + 4 * lane + 256 * j);
        for (int r0 = gw * 4; r0 < M; r0 += NGW * 4) {
            v2u w[4][4]; float rs[4];
#pragma unroll
            for (int q = 0; q < 4; ++q) { const bf16* hp = HB + (size_t)pg8::hbrow(r0 + q) * D + 4 * lane; rs[q] = rs_of(ssq4[r0 + q]);
#pragma unroll
                for (int j = 0; j < 4; ++j) w[q][j] = __builtin_nontemporal_load((const v2u*)(hp + 256 * j)); }
#pragma unroll
            for (int q = 0; q < 4; ++q) { float* p = out + (size_t)(r0 + q) * D + 4 * lane;
#pragma unroll
                for (int j = 0; j < 4; ++j) { const f32x4 v = {bflo(w[q][j].x), bfhi(w[q][j].x), bflo(w[q][j].y), bfhi(w[q][j].y)}; __builtin_nontemporal_store(v * rs[q] * gv[j], (f32x4*)(p + 256 * j)); } }
        }
    }
    PROBE_MARK(10);
#if PROBE_A >= 0
    if (bx == 0 && tid == 0) { const unsigned long long qa = (dA + 500) / 1000, qb = (dB + 500) / 1000;
        const unsigned long long spin = (PROBE_B >= 0) ? qa * 100000ull + qb * 5000ull : dA * 10ull; const unsigned long long t0 = __builtin_amdgcn_s_memrealtime();
        while (__builtin_amdgcn_s_memrealtime() - t0 < spin) __builtin_amdgcn_s_sleep(32); }
#endif
#undef IN
#undef SEAM
}

extern "C" void kernel_launch(void* const* d_in, const int* in_sizes, int n_in, void* d_out, int out_size, void* d_ws, size_t ws_size, hipStream_t stream) {
    static int grid = 0;
    if (grid == 0) {
        if (n_in != 15 || in_sizes[0] != M * D || out_size != M * D || ws_size < WS_END) { fprintf(stderr, "kernel_launch: unexpected shapes (n_in %d, in0 %d, out %d, ws %zu, need %zu); nothing launched\n", n_in, n_in > 0 ? in_sizes[0] : -1, out_size, ws_size, (size_t)WS_END); grid = -1; return; }
        int dev = 0, cus = 0, per_cu = 0;
        if (hipGetDevice(&dev) != hipSuccess || hipDeviceGetAttribute(&cus, hipDeviceAttributeMultiprocessorCount, dev) != hipSuccess) { grid = -1; return; }
        if (hipFuncSetAttribute((const void*)yoco_fwd, hipFuncAttributeMaxDynamicSharedMemorySize, LDS_BYTES) != hipSuccess) { fprintf(stderr, "kernel_launch: hipFuncSetAttribute failed\n"); grid = -1; return; }
        if (hipOccupancyMaxActiveBlocksPerMultiprocessor(&per_cu, (const void*)yoco_fwd, NTHREADS, LDS_BYTES) != hipSuccess || per_cu < 1) per_cu = 1;
        (void)hipGetLastError();
        grid = cus * per_cu;
    }
    if (grid < 0) return;
    if (hipMemsetAsync((char*)d_ws + WS_CTL, 0, CTL_BYTES, stream) != hipSuccess) { fprintf(stderr, "kernel_launch: hipMemsetAsync failed\n"); return; }
    Args a{};
    for (int i = 0; i < 15; ++i) a.in[i] = (const float*)d_in[i];
    a.out = (float*)d_out; a.ws = (unsigned char*)d_ws;
#if MK_N_LAUNCHES == 1
    a.ph_lo = 0; a.ph_hi = NPHASES;
    void* kargs[] = {&a};
    hipError_t e = hipLaunchCooperativeKernel((const void*)yoco_fwd, dim3(grid), dim3(NTHREADS), kargs, LDS_BYTES, stream);
    if (e != hipSuccess) fprintf(stderr, "kernel_launch: cooperative launch failed: %s (grid %d)\n", hipGetErrorString(e), grid);
#else
    for (int p = 0; p < NPHASES; ++p) { a.ph_lo = p; a.ph_hi = p + 1; hipLaunchKernelGGL(yoco_fwd, dim3(grid), dim3(NTHREADS), LDS_BYTES, stream, a); }
#endif
}
```
